# Optimizing an MI355X kernel written in HIP

```python
import math
import jax
import jax.numpy as jnp
from jax import lax
import numpy as np


D_MODEL = 1024
BATCH = 8
SEQ = 4096
DEPTH = 2
DEC_BATCH = 32
DEC_SEQ = 2048
PAST_LEN = 128

GRID_W = 64
N_EVEN = (DEPTH + 1) // 2
N_ODD = DEPTH // 2

S5_WIDTH = D_MODEL // 2
S5_GROUP = 16
S5_GROUPS = S5_WIDTH // S5_GROUP
S5_STATE = 64
DT_MIN = 1e-3
DT_MAX = 1e-1

NA_HEAD_DIM = 64
NA_HEADS = (D_MODEL // 2) // NA_HEAD_DIM
NA_WIDTH = NA_HEADS * NA_HEAD_DIM
NA_ROWS_MAX = 8
NA_COLS = 16

EVEN_IN = S5_WIDTH + 3 * NA_WIDTH
EVEN_MIX = S5_WIDTH + NA_WIDTH

GQA_HEAD_DIM = 64
GQA_HEADS = D_MODEL // GQA_HEAD_DIM
GQA_KV_HEADS = GQA_HEADS // 4
GQA_GROUP = GQA_HEADS // GQA_KV_HEADS
WINDOW = 128
BLOCK = 128
ODD_IN = (GQA_HEADS + 2 * GQA_KV_HEADS) * GQA_HEAD_DIM
ODD_MIX = GQA_HEADS * GQA_HEAD_DIM

T5_BUCKETS = 32
T5_MAX_DIST = 128

D_FF = 2816
RMS_EPS = 1e-6
NEG_INF = -1e30

kernel_name = 'hybrid_s5_natten_swa_encoder'


def rms_norm(x, g):
    xf = x.astype(jnp.float32)
    y = xf * lax.rsqrt(jnp.mean(xf * xf, axis=-1, keepdims=True) + RMS_EPS)
    return (y * g.astype(jnp.float32)).astype(x.dtype)


def swiglu(x, wg, wu, wd):
    return (jax.nn.silu(x @ wg) * (x @ wu)) @ wd


def _cmul(ar, ai, br, bi):
    return ar * br - ai * bi, ar * bi + ai * br


def _ssm_combine(e1, e2):
    a1r, a1i, b1r, b1i = e1
    a2r, a2i, b2r, b2i = e2
    ar, ai = _cmul(a2r, a2i, a1r, a1i)
    br, bi = _cmul(a2r, a2i, b1r, b1i)
    return ar, ai, br + b2r, bi + b2i


def s5_scan(ug, lam_re, lam_im, log_dt, b_re, b_im, c_re, c_im, reverse):
    dt = jnp.exp(log_dt)[:, None]
    mag = jnp.exp(lam_re * dt)
    ab_re = mag * jnp.cos(lam_im * dt)
    ab_im = mag * jnp.sin(lam_im * dt)
    den = lam_re * lam_re + lam_im * lam_im
    nr = ab_re - 1.0
    cr = (nr * lam_re + ab_im * lam_im) / den
    ci = (ab_im * lam_re - nr * lam_im) / den
    bb_re = cr[..., None] * b_re - ci[..., None] * b_im
    bb_im = cr[..., None] * b_im + ci[..., None] * b_re
    bu_re = jnp.einsum('blgc,gpc->blgp', ug, bb_re)
    bu_im = jnp.einsum('blgc,gpc->blgp', ug, bb_im)
    a_re = jnp.broadcast_to(ab_re, bu_re.shape)
    a_im = jnp.broadcast_to(ab_im, bu_im.shape)
    _, _, s_re, s_im = lax.associative_scan(_ssm_combine, (a_re, a_im, bu_re, bu_im), reverse=reverse, axis=1)
    return jnp.einsum('blgp,gcp->blgc', s_re, c_re) - jnp.einsum('blgp,gcp->blgc', s_im, c_im)


def s5_mixer(u, lam_re, lam_im, log_dt, b_re, b_im, c_re, c_im, d_skip, w_glu, b_glu):
    bsz, seq = u.shape[0], u.shape[1]
    f32 = jnp.float32
    uf = u.astype(f32)
    ug = uf.reshape(bsz, seq, S5_GROUPS, S5_GROUP)
    y = d_skip.astype(f32) * uf
    for direction in range(2):
        yd = s5_scan(ug, lam_re[direction].astype(f32), lam_im[direction].astype(f32),
                     log_dt[direction].astype(f32), b_re[direction].astype(f32), b_im[direction].astype(f32),
                     c_re[direction].astype(f32), c_im[direction].astype(f32), reverse=(direction == 1))
        y = y + yd.reshape(bsz, seq, S5_WIDTH)
    g = jax.nn.gelu(y)
    out = g * jax.nn.sigmoid(g @ w_glu.astype(f32) + b_glu.astype(f32))
    return out.astype(u.dtype)


def neighbourhood_attention(q, k, v, rpb):
    bsz, seq, h, dh = q.shape
    rows = seq // GRID_W
    kh = min(NA_ROWS_MAX, rows)
    kw = NA_COLS
    f32 = jnp.float32
    qg = q.reshape(bsz, rows, GRID_W, h, dh)
    kg = k.reshape(bsz, rows, GRID_W, h, dh)
    vg = v.reshape(bsz, rows, GRID_W, h, dh)
    row_start = jnp.clip(jnp.arange(rows) - kh // 2, 0, rows - kh)
    rel_row = row_start[:, None] + jnp.arange(kh)[None, :] - jnp.arange(rows)[:, None]
    col_idx = jnp.clip(jnp.arange(GRID_W) - kw // 2, 0, GRID_W - kw)[:, None] + jnp.arange(kw)[None, :]
    rel_col = col_idx - jnp.arange(GRID_W)[:, None]
    scale = dh ** -0.5

    def one_row(args):
        q_r, rs, rr = args
        k_win = lax.dynamic_slice_in_dim(kg, rs, kh, axis=1)[:, :, col_idx]
        v_win = lax.dynamic_slice_in_dim(vg, rs, kh, axis=1)[:, :, col_idx]
        bias = rpb[:, rr[:, None, None] + NA_ROWS_MAX - 1, rel_col[None] + NA_COLS - 1]
        bias = jnp.transpose(bias, (2, 0, 1, 3)).astype(f32)
        s = jnp.einsum('bqhd,bkqjhd->bqhkj', q_r, k_win).astype(f32) * scale + bias[None]
        p = jax.nn.softmax(s.reshape(bsz, GRID_W, h, kh * kw), axis=-1).reshape(s.shape)
        return jnp.einsum('bqhkj,bkqjhd->bqhd', p.astype(v.dtype), v_win)

    out = lax.map(one_row, (jnp.moveaxis(qg, 1, 0), row_start, rel_row))
    return jnp.moveaxis(out, 0, 1).reshape(bsz, seq, h * dh)


def t5_bucket(rel):
    half = T5_BUCKETS // 2
    max_exact = half // 2
    ret = jnp.where(rel > 0, half, 0)
    n = jnp.abs(rel)
    nf = jnp.maximum(n, 1).astype(jnp.float32)
    large = max_exact + (jnp.log(nf / max_exact) / math.log(T5_MAX_DIST / max_exact)
                         * (half - max_exact)).astype(jnp.int32)
    large = jnp.minimum(large, half - 1)
    return ret + jnp.where(n < max_exact, n, large)


def windowed_gqa(q, k, v, sink, t5_table):
    bsz, seq = q.shape[0], q.shape[1]
    nb = seq // BLOCK
    f32 = jnp.float32
    qb = jnp.moveaxis(q.reshape(bsz, nb, BLOCK, GQA_KV_HEADS, GQA_GROUP, GQA_HEAD_DIM), 1, 0)
    pad = ((0, 0), (BLOCK, BLOCK), (0, 0), (0, 0))
    kp = jnp.pad(k, pad)
    vp = jnp.pad(v, pad)
    qi = jnp.arange(BLOCK)[:, None]
    kj = jnp.arange(3 * BLOCK)[None, :]
    rel = kj - BLOCK - qi
    bias = jnp.transpose(t5_table[t5_bucket(rel)], (2, 0, 1)).astype(f32)
    bias = bias.reshape(GQA_KV_HEADS, GQA_GROUP, BLOCK, 3 * BLOCK)
    in_window = jnp.abs(rel) <= WINDOW
    sk = sink.astype(f32).reshape(GQA_KV_HEADS, GQA_GROUP)[None, :, :, None, None]
    scale = GQA_HEAD_DIM ** -0.5

    def one_block(args):
        q_n, n = args
        start = n * BLOCK
        k_n = lax.dynamic_slice_in_dim(kp, start, 3 * BLOCK, axis=1)
        v_n = lax.dynamic_slice_in_dim(vp, start, 3 * BLOCK, axis=1)
        kpos = start + kj - BLOCK
        valid = in_window & (kpos >= 0) & (kpos < seq)
        s = jnp.einsum('bqgrd,bkgd->bgrqk', q_n, k_n).astype(f32) * scale + bias[None]
        s = jnp.where(valid, s, NEG_INF)
        m = jnp.maximum(jnp.max(s, axis=-1, keepdims=True), sk)
        p = jnp.exp(s - m)
        denom = jnp.sum(p, axis=-1, keepdims=True) + jnp.exp(sk - m)
        return jnp.einsum('bgrqk,bkgd->bqgrd', (p / denom).astype(v.dtype), v_n)

    out = lax.map(one_block, (qb, jnp.arange(nb)))
    return jnp.moveaxis(out, 0, 1).reshape(bsz, seq, ODD_MIX)


def trunk(x, norm_ffn, w_ffn_gate, w_ffn_up, w_ffn_down, norm_mix, w_in_even,
          s5_lam_re, s5_lam_im, s5_log_dt, s5_b_re, s5_b_im, s5_c_re, s5_c_im,
          s5_d, s5_w_glu, s5_b_glu, na_rpb, w_out_even, w_in_odd, gqa_sink, w_out_odd,
          t5_table, norm_final):
    bsz, seq = x.shape[0], x.shape[1]
    for layer in range(DEPTH):
        i = layer // 2
        x = x + 0.5 * swiglu(rms_norm(x, norm_ffn[layer, 0]), w_ffn_gate[layer, 0],
                             w_ffn_up[layer, 0], w_ffn_down[layer, 0])
        hn = rms_norm(x, norm_mix[layer])
        if layer % 2 == 0:
            z = hn @ w_in_even[i]
            u = z[..., :S5_WIDTH]
            q, k, v = jnp.split(z[..., S5_WIDTH:], 3, axis=-1)
            q = q.reshape(bsz, seq, NA_HEADS, NA_HEAD_DIM)
            k = k.reshape(bsz, seq, NA_HEADS, NA_HEAD_DIM)
            v = v.reshape(bsz, seq, NA_HEADS, NA_HEAD_DIM)
            y_a = s5_mixer(u, s5_lam_re[i], s5_lam_im[i], s5_log_dt[i], s5_b_re[i], s5_b_im[i],
                           s5_c_re[i], s5_c_im[i], s5_d[i], s5_w_glu[i], s5_b_glu[i])
            y_b = neighbourhood_attention(q, k, v, na_rpb[i])
            x = x + jnp.concatenate([y_a, y_b], axis=-1) @ w_out_even[i]
        else:
            z = hn @ w_in_odd[i]
            nq = GQA_HEADS * GQA_HEAD_DIM
            nkv = GQA_KV_HEADS * GQA_HEAD_DIM
            q = z[..., :nq].reshape(bsz, seq, GQA_HEADS, GQA_HEAD_DIM)
            k = z[..., nq:nq + nkv].reshape(bsz, seq, GQA_KV_HEADS, GQA_HEAD_DIM)
            v = z[..., nq + nkv:].reshape(bsz, seq, GQA_KV_HEADS, GQA_HEAD_DIM)
            x = x + windowed_gqa(q, k, v, gqa_sink[i], t5_table) @ w_out_odd[i]
        x = x + 0.5 * swiglu(rms_norm(x, norm_ffn[layer, 1]), w_ffn_gate[layer, 1],
                             w_ffn_up[layer, 1], w_ffn_down[layer, 1])
    return rms_norm(x, norm_final)


def setup_inputs(seed: int = 0) -> dict:
    key = jax.random.key(seed)
    ks = jax.random.split(key, 32)
    f = jnp.float32

    def nrm(k, shape, scale):
        return jax.random.normal(k, shape, f) * scale

    lam_im_base = jnp.pi * jnp.arange(S5_STATE, dtype=f)
    return {
        'x_prompt': nrm(ks[0], (BATCH, SEQ, D_MODEL), 1.0),
        'x_sample': nrm(ks[1], (DEC_BATCH, DEC_SEQ, D_MODEL), 1.0),
        'norm_ffn': 1.0 + nrm(ks[2], (DEPTH, 2, D_MODEL), 0.02),
        'w_ffn_gate': nrm(ks[3], (DEPTH, 2, D_MODEL, D_FF), D_MODEL ** -0.5),
        'w_ffn_up': nrm(ks[4], (DEPTH, 2, D_MODEL, D_FF), D_MODEL ** -0.5),
        'w_ffn_down': nrm(ks[5], (DEPTH, 2, D_FF, D_MODEL), D_FF ** -0.5),
        'norm_mix': 1.0 + nrm(ks[6], (DEPTH, D_MODEL), 0.02),
        'w_in_even': nrm(ks[7], (N_EVEN, D_MODEL, EVEN_IN), D_MODEL ** -0.5),
        's5_lam_re': -0.5 + nrm(ks[8], (N_EVEN, 2, S5_GROUPS, S5_STATE), 0.01),
        's5_lam_im': lam_im_base + nrm(ks[9], (N_EVEN, 2, S5_GROUPS, S5_STATE), 0.01),
        's5_log_dt': jax.random.uniform(ks[10], (N_EVEN, 2, S5_GROUPS), f,
                                        minval=math.log(DT_MIN), maxval=math.log(DT_MAX)),
        's5_b_re': nrm(ks[11], (N_EVEN, 2, S5_GROUPS, S5_STATE, S5_GROUP), S5_GROUP ** -0.5),
        's5_b_im': nrm(ks[12], (N_EVEN, 2, S5_GROUPS, S5_STATE, S5_GROUP), S5_GROUP ** -0.5),
        's5_c_re': nrm(ks[13], (N_EVEN, 2, S5_GROUPS, S5_GROUP, S5_STATE), S5_STATE ** -0.5),
        's5_c_im': nrm(ks[14], (N_EVEN, 2, S5_GROUPS, S5_GROUP, S5_STATE), S5_STATE ** -0.5),
        's5_d': nrm(ks[15], (N_EVEN, S5_WIDTH), 1.0),
        's5_w_glu': nrm(ks[16], (N_EVEN, S5_WIDTH, S5_WIDTH), S5_WIDTH ** -0.5),
        's5_b_glu': nrm(ks[17], (N_EVEN, S5_WIDTH), 0.01),
        'na_rpb': nrm(ks[18], (N_EVEN, NA_HEADS, 2 * NA_ROWS_MAX - 1, 2 * NA_COLS - 1), 0.1),
        'w_out_even': nrm(ks[19], (N_EVEN, EVEN_MIX, D_MODEL), EVEN_MIX ** -0.5),
        'w_in_odd': nrm(ks[20], (N_ODD, D_MODEL, ODD_IN), D_MODEL ** -0.5),
        'gqa_sink': nrm(ks[21], (N_ODD, GQA_HEADS), 0.5),
        'w_out_odd': nrm(ks[22], (N_ODD, ODD_MIX, D_MODEL), ODD_MIX ** -0.5),
        't5_table': nrm(ks[23], (T5_BUCKETS, GQA_HEADS), 0.5),
        'norm_final': 1.0 + nrm(ks[24], (D_MODEL,), 0.02),
    }


def reference(x_prompt, x_sample, norm_ffn, w_ffn_gate, w_ffn_up, w_ffn_down, norm_mix, w_in_even,
              s5_lam_re, s5_lam_im, s5_log_dt, s5_b_re, s5_b_im, s5_c_re, s5_c_im,
              s5_d, s5_w_glu, s5_b_glu, na_rpb, w_out_even, w_in_odd, gqa_sink, w_out_odd,
              t5_table, norm_final):
    y_prompt = trunk(x_prompt, norm_ffn, w_ffn_gate, w_ffn_up, w_ffn_down, norm_mix, w_in_even,
                     s5_lam_re, s5_lam_im, s5_log_dt, s5_b_re, s5_b_im, s5_c_re, s5_c_im,
                     s5_d, s5_w_glu, s5_b_glu, na_rpb, w_out_even, w_in_odd, gqa_sink, w_out_odd,
                     t5_table, norm_final)
    y_sample = trunk(x_sample, norm_ffn, w_ffn_gate, w_ffn_up, w_ffn_down, norm_mix, w_in_even,
                     s5_lam_re, s5_lam_im, s5_log_dt, s5_b_re, s5_b_im, s5_c_re, s5_c_im,
                     s5_d, s5_w_glu, s5_b_glu, na_rpb, w_out_even, w_in_odd, gqa_sink, w_out_odd,
                     t5_table, norm_final)
    return (y_prompt, y_sample)
```

```cpp
#include <hip/hip_runtime.h>
#include <hip/hip_cooperative_groups.h>
#include <cstdio>
#include <cstdint>
#include <cmath>
namespace cg = cooperative_groups;
namespace pg8 {
#define PG8_LAS __attribute__((address_space(3)))
typedef unsigned short bf16_t;
typedef short bf16x8 __attribute__((ext_vector_type(8)));
typedef float f32x4 __attribute__((ext_vector_type(4)));
typedef unsigned u32x4 __attribute__((ext_vector_type(4)));
constexpr int BM = 256, BK = 64, HALF = 128, HTB = HALF * BK * 2  , STAGE_BYTES = 8 * HTB, NXCD = 8, WGM = 8;

__host__ __device__ __forceinline__ int lds_byte(int r, int c) { const int st = (r >> 4) * 2 + (c >> 5), rr = r & 15, cc = c & 31, ob = rr * 64 + cc * 2; return st * 1024 + (ob ^ (((ob >> 9) & 1) << 5)); }
__host__ __device__ __forceinline__ void stage_rc(int b, int& R, int& C) { const int st = b / 1024, sb = b % 1024, swz = sb ^ (((sb >> 9) & 1) << 5); R = (st >> 1) * 16 + swz / 64; C = (st & 1) * 32 + (swz % 64) / 2; }
__host__ __device__ __forceinline__ int perm32(int rho) { const int n = rho >> 4, i = rho & 15; return 8 * (i >> 2) + 4 * n + (i & 3); }

struct Unit { int pm, pn; };
struct Gemm { const bf16_t* A; const bf16_t* Bt; int M, N, K; };

struct StaticOrder {
    int nM, nN, nwg, G, c;
    __host__ __device__ void init(int M, int N, int G_, int c_) { nM = M / BM; nN = N / BM; nwg = nM * nN; G = G_; c = c_; }
    __host__ __device__ bool next(int i, Unit& u) const {
        const long L = (long)i * G + c; if (L >= nwg) return false;
        int wgid = (int)L; { const int q = nwg / NXCD, r = nwg % NXCD, xcd = wgid % NXCD, off = wgid / NXCD; wgid = (xcd < r ? xcd * (q + 1) : r * (q + 1) + (xcd - r) * q) + off; }
        const int nig = WGM * nN, gid = wgid / nig, fm = gid * WGM, gsz = (nM - fm) < WGM ? (nM - fm) : WGM;
        u.pm = fm + ((wgid % nig) % gsz); u.pn = (wgid % nig) / gsz; return true;
    }
    __device__ __forceinline__ void a_ready(const Unit&) const {}
    __device__ __forceinline__ void done(const Unit&) const {}
};
__device__ __forceinline__ unsigned cvt_pk_bf16(float lo, float hi) { unsigned r; asm volatile("v_cvt_pk_bf16_f32 %0, %1, %2" : "=v"(r) : "v"(lo), "v"(hi)); return r; }
typedef float f32x2 __attribute__((ext_vector_type(2)));
typedef unsigned u32x2 __attribute__((ext_vector_type(2)));
__device__ __forceinline__ float fast_sigmoid(float v) { return __builtin_amdgcn_rcpf(1.0f + __expf(-v)); }
__device__ __forceinline__ float rstd16(const float* p) {
    const f32x4 a = *(const f32x4*)p, b = *(const f32x4*)(p + 4), c = *(const f32x4*)(p + 8), d = *(const f32x4*)(p + 12);
    const float s = (((a[0] + a[1]) + (a[2] + a[3])) + ((b[0] + b[1]) + (b[2] + b[3]))) + (((c[0] + c[1]) + (c[2] + c[3])) + ((d[0] + d[1]) + (d[2] + d[3])));
    return __builtin_amdgcn_rsqf(s * (1.0f / 1024.0f) + 1e-6f);
}
__device__ __forceinline__ float rstd16q(const float* p, int fq) {
    const f32x4 a = *(const f32x4*)(p + 4 * fq);
    float s = (a[0] + a[1]) + (a[2] + a[3]);
    s += __shfl_xor(s, 16); s += __shfl_xor(s, 32);
    return __builtin_amdgcn_rsqf(s * (1.0f / 1024.0f) + 1e-6f);
}
struct EpiSwiGLU {
    static constexpr bool PERM = true, AFTER_DRAIN = false;
    __device__ __forceinline__ void prefetch(const Unit&, int, int, int, int, PG8_LAS unsigned char*, int) const {}
    bf16_t* H; int ldh; const float* ssq;
    PG8_LAS float* rcache;
    __device__ __forceinline__ void operator()(const f32x4 (&acc)[2][2][4][2], const Unit& u, int wr, int wc, int fr, int fq) const {
        const int row0 = u.pm * BM + wr * 64 + fr, col0 = u.pn * HALF + wc * 32 + 8 * fq;
        float rsv[2][4];
        const int wid_ = wr * 4 + wc;
        PG8_LAS float* rc = rcache + wid_ * 128 + fr;
        PG8_LAS int* tag = (PG8_LAS int*)(rcache + 1024) + wid_;
        if (*tag != u.pm) {
            f32x4 pq[2][4];
#pragma unroll
            for (int ai = 0; ai < 2; ++ai)
#pragma unroll
                for (int m = 0; m < 4; ++m) pq[ai][m] = *(const f32x4*)(ssq + (size_t)(row0 + ai * HALF + m * 16) * 16 + 4 * fq);
#pragma unroll
            for (int ai = 0; ai < 2; ++ai)
#pragma unroll
                for (int m = 0; m < 4; ++m) { float s = (pq[ai][m][0] + pq[ai][m][1]) + (pq[ai][m][2] + pq[ai][m][3]); s += __shfl_xor(s, 16); s += __shfl_xor(s, 32); rsv[ai][m] = __builtin_amdgcn_rsqf(s * (1.0f / 1024.0f) + 1e-6f);
                    if (fq == 0) rc[(ai * 4 + m) * 16] = rsv[ai][m]; }
            if (fr == 0 && fq == 0) *tag = u.pm;
        } else {
#pragma unroll
            for (int ai = 0; ai < 2; ++ai)
#pragma unroll
                for (int m = 0; m < 4; ++m) rsv[ai][m] = rc[(ai * 4 + m) * 16];
        }
#pragma unroll
        for (int ai = 0; ai < 2; ++ai)
#pragma unroll
            for (int m = 0; m < 4; ++m) {
                bf16_t* rowp = H + (size_t)(row0 + ai * HALF + m * 16) * ldh + col0;
                const float rs = rsv[ai][m], rsl = rs * -1.4426950408889634f, rs2 = rs * rs;
                float tq[8], pq8[8], hv[8];
#pragma unroll
                for (int k = 0; k < 8; ++k) { tq[k] = acc[ai][0][m][k >> 2][k & 3] * rsl; asm volatile("" : "+v"(tq[k])); }
#pragma unroll
                for (int k = 0; k < 8; ++k) { tq[k] = __builtin_amdgcn_exp2f(tq[k]); asm volatile("" : "+v"(tq[k])); }
#pragma unroll
                for (int k = 0; k < 8; ++k) { pq8[k] = acc[ai][0][m][k >> 2][k & 3] * acc[ai][1][m][k >> 2][k & 3]; asm volatile("" : "+v"(pq8[k])); }
#pragma unroll
                for (int k = 0; k < 8; ++k) { tq[k] = tq[k] + 1.0f; asm volatile("" : "+v"(tq[k])); }
#pragma unroll
                for (int k = 0; k < 8; ++k) { tq[k] = __builtin_amdgcn_rcpf(tq[k]); asm volatile("" : "+v"(tq[k])); }
#pragma unroll
                for (int k = 0; k < 8; ++k) { pq8[k] = pq8[k] * rs2; asm volatile("" : "+v"(pq8[k])); }
#pragma unroll
                for (int k = 0; k < 8; ++k) hv[k] = pq8[k] * tq[k];
                u32x4 w; w.x = cvt_pk_bf16(hv[0], hv[1]); w.y = cvt_pk_bf16(hv[2], hv[3]); w.z = cvt_pk_bf16(hv[4], hv[5]); w.w = cvt_pk_bf16(hv[6], hv[7]);
                __builtin_nontemporal_store(w, (u32x4*)rowp);
            }
    }
};
struct EpiResAdd {
    static constexpr bool PERM = true, AFTER_DRAIN = false;
    bf16_t* XB; int ldx; float scale; float* ssq;
    __device__ __forceinline__ void prefetch(const Unit& u, int wr, int wc, int fr, int fq, PG8_LAS unsigned char* lds, int wid) const {
        PG8_LAS unsigned* dummy = (PG8_LAS unsigned*)(lds + 131072 + 1024 + wid * 256);
        const unsigned lane_off = (unsigned)(fr * ldx + 8 * fq) * 2u;
        const char* ub = (const char*)XB + ((size_t)(u.pm * BM + wr * 64) * ldx + u.pn * BM + wc * 32) * 2;
#pragma unroll
        for (int ai = 0; ai < 2; ++ai)
#pragma unroll
            for (int m = 0; m < 4; ++m)
#pragma unroll
                for (int bj = 0; bj < 2; ++bj) {
                    const char* up = ub + ((size_t)(ai * HALF + m * 16) * ldx + bj * HALF) * 2;
                    __builtin_amdgcn_global_load_lds((const unsigned*)(up + lane_off), dummy, 4, 0, 0);
                }
    }
    __device__ __forceinline__ void operator()(const f32x4 (&acc)[2][2][4][2], const Unit& u, int wr, int wc, int fr, int fq) const {
        const int row0 = u.pm * BM + wr * 64 + fr, col0 = u.pn * BM + wc * 32 + 8 * fq;
        const unsigned lane_off = (unsigned)(fr * ldx + 8 * fq) * 2u;
        const char* ub = (const char*)XB + ((size_t)(u.pm * BM + wr * 64) * ldx + u.pn * BM + wc * 32) * 2;
        u32x4 ow[2][4][2];
#pragma unroll
        for (int ai = 0; ai < 2; ++ai)
#pragma unroll
            for (int m = 0; m < 4; ++m)
#pragma unroll
                for (int bj = 0; bj < 2; ++bj) ow[ai][m][bj] = *(const u32x4*)(ub + ((size_t)(ai * HALF + m * 16) * ldx + bj * HALF) * 2 + lane_off);
#pragma unroll
        for (int ai = 0; ai < 2; ++ai)
#pragma unroll
            for (int m = 0; m < 4; ++m) {
                char* bp = (char*)ub + (size_t)(ai * HALF + m * 16) * ldx * 2;
                float sq = 0.f;
#pragma unroll
                for (int bj = 0; bj < 2; ++bj) {
                    const u32x4 w0 = ow[ai][m][bj];
                    const f32x4 a0 = acc[ai][bj][m][0] * scale, a1 = acc[ai][bj][m][1] * scale;
                    float o[8];
                    o[0] = __uint_as_float(w0.x << 16) + a0[0]; o[1] = __uint_as_float(w0.x & 0xffff0000u) + a0[1]; o[2] = __uint_as_float(w0.y << 16) + a0[2]; o[3] = __uint_as_float(w0.y & 0xffff0000u) + a0[3];
                    o[4] = __uint_as_float(w0.z << 16) + a1[0]; o[5] = __uint_as_float(w0.z & 0xffff0000u) + a1[1]; o[6] = __uint_as_float(w0.w << 16) + a1[2]; o[7] = __uint_as_float(w0.w & 0xffff0000u) + a1[3];
                    sq += ((o[0] * o[0] + o[1] * o[1]) + (o[2] * o[2] + o[3] * o[3])) + ((o[4] * o[4] + o[5] * o[5]) + (o[6] * o[6] + o[7] * o[7]));
                    u32x4 w; w.x = cvt_pk_bf16(o[0], o[1]); w.y = cvt_pk_bf16(o[2], o[3]); w.z = cvt_pk_bf16(o[4], o[5]); w.w = cvt_pk_bf16(o[6], o[7]);
                    *(u32x4*)(bp + bj * HALF * 2 + lane_off) = w;
                }
                sq += __shfl_xor(sq, 16); sq += __shfl_xor(sq, 32);
                if (fq == 0) ssq[(size_t)(row0 + ai * HALF + m * 16) * 16 + u.pn * 4 + wc] = sq;
            }
    }
};
struct EpiStore {
    static constexpr bool PERM = true, AFTER_DRAIN = false;
    __device__ __forceinline__ void prefetch(const Unit&, int, int, int, int, PG8_LAS unsigned char*, int) const {}
    bf16_t* O; size_t ldc; const float* ssq; int colmode;
    __device__ __forceinline__ void operator()(const f32x4 (&acc)[2][2][4][2], const Unit& u, int wr, int wc, int fr, int fq) const {
        const int row0 = u.pm * BM + wr * 64 + fr, col0 = u.pn * BM + wc * 32 + 8 * fq;
        float rsv[2][4], crs[2][8];
#pragma unroll
        for (int bj = 0; bj < 2; ++bj)
#pragma unroll
            for (int k = 0; k < 8; ++k) crs[bj][k] = 1.0f;
        if (!colmode) {
            f32x4 pq[2][4];
#pragma unroll
            for (int ai = 0; ai < 2; ++ai)
#pragma unroll
                for (int m = 0; m < 4; ++m) pq[ai][m] = *(const f32x4*)(ssq + (size_t)(row0 + ai * HALF + m * 16) * 16 + 4 * fq);
#pragma unroll
            for (int ai = 0; ai < 2; ++ai)
#pragma unroll
                for (int m = 0; m < 4; ++m) { float s = (pq[ai][m][0] + pq[ai][m][1]) + (pq[ai][m][2] + pq[ai][m][3]); s += __shfl_xor(s, 16); s += __shfl_xor(s, 32); rsv[ai][m] = __builtin_amdgcn_rsqf(s * (1.0f / 1024.0f) + 1e-6f); }
        } else {
#pragma unroll
            for (int ai = 0; ai < 2; ++ai)
#pragma unroll
                for (int m = 0; m < 4; ++m) rsv[ai][m] = 1.0f;
#pragma unroll
            for (int bj = 0; bj < 2; ++bj)
#pragma unroll
                for (int hf = 0; hf < 2; ++hf) {
                    f32x4 q[4][4];
#pragma unroll
                    for (int j = 0; j < 4; ++j)
#pragma unroll
                        for (int t = 0; t < 4; ++t) q[j][t] = *(const f32x4*)(ssq + (size_t)(col0 + bj * HALF + hf * 4 + j) * 16 + 4 * t);
#pragma unroll
                    for (int j = 0; j < 4; ++j) {
                        const f32x4 a = q[j][0], b = q[j][1], c = q[j][2], d = q[j][3];
                        const float s = (((a[0] + a[1]) + (a[2] + a[3])) + ((b[0] + b[1]) + (b[2] + b[3]))) + (((c[0] + c[1]) + (c[2] + c[3])) + ((d[0] + d[1]) + (d[2] + d[3])));
                        crs[bj][hf * 4 + j] = __builtin_amdgcn_rsqf(s * (1.0f / 1024.0f) + 1e-6f);
                    }
                }
        }
#pragma unroll
        for (int ai = 0; ai < 2; ++ai)
#pragma unroll
            for (int m = 0; m < 4; ++m) {
                bf16_t* rowp = O + (size_t)(row0 + ai * HALF + m * 16) * ldc + col0;
                const float rr = rsv[ai][m];
#pragma unroll
                for (int bj = 0; bj < 2; ++bj) { f32x4 v0 = acc[ai][bj][m][0] * rr, v1 = acc[ai][bj][m][1] * rr;
                    if (colmode) {
#pragma unroll
                        for (int j = 0; j < 4; ++j) { v0[j] *= crs[bj][j]; v1[j] *= crs[bj][4 + j]; } }
                    u32x4 w; w.x = cvt_pk_bf16(v0[0], v0[1]); w.y = cvt_pk_bf16(v0[2], v0[3]); w.z = cvt_pk_bf16(v1[0], v1[1]); w.w = cvt_pk_bf16(v1[2], v1[3]);
                    *(u32x4*)(rowp + bj * HALF) = w; }
            }
    }
};
struct EpiGLU {
    static constexpr bool PERM = true, AFTER_DRAIN = false;
    __device__ __forceinline__ void prefetch(const Unit&, int, int, int, int, PG8_LAS unsigned char*, int) const {}
    const bf16_t* G; int ldg; const float* bias; bf16_t* O; int ldo;
    __device__ __forceinline__ void operator()(const f32x4 (&acc)[2][2][4][2], const Unit& u, int wr, int wc, int fr, int fq) const {
        const int row0 = u.pm * BM + wr * 64 + fr, col0 = u.pn * BM + wc * 32 + 8 * fq;
        u32x4 gw_[2][2][4];
#pragma unroll
        for (int bj = 0; bj < 2; ++bj)
#pragma unroll
            for (int ai = 0; ai < 2; ++ai)
#pragma unroll
                for (int m = 0; m < 4; ++m) gw_[bj][ai][m] = *(const u32x4*)(G + (size_t)(row0 + ai * HALF + m * 16) * ldg + col0 + bj * HALF);
#pragma unroll
        for (int bj = 0; bj < 2; ++bj) {
            const f32x4 b0 = *(const f32x4*)(bias + col0 + bj * HALF), b1 = *(const f32x4*)(bias + col0 + bj * HALF + 4);
#pragma unroll
            for (int ai = 0; ai < 2; ++ai)
#pragma unroll
                for (int m = 0; m < 4; ++m) {
                    const size_t r = (size_t)(row0 + ai * HALF + m * 16);
                    const u32x4 gw = gw_[bj][ai][m];
                    const f32x4 v0 = acc[ai][bj][m][0] + b0, v1 = acc[ai][bj][m][1] + b1;
                    float gv[8];
                    gv[0] = __uint_as_float(gw.x << 16); gv[1] = __uint_as_float(gw.x & 0xffff0000u); gv[2] = __uint_as_float(gw.y << 16); gv[3] = __uint_as_float(gw.y & 0xffff0000u);
                    gv[4] = __uint_as_float(gw.z << 16); gv[5] = __uint_as_float(gw.z & 0xffff0000u); gv[6] = __uint_as_float(gw.w << 16); gv[7] = __uint_as_float(gw.w & 0xffff0000u);
                    float ov[8];
#pragma unroll
                    for (int j = 0; j < 4; ++j) { ov[j] = gv[j] * fast_sigmoid(v0[j]); ov[4 + j] = gv[4 + j] * fast_sigmoid(v1[j]); }
                    u32x4 w; w.x = cvt_pk_bf16(ov[0], ov[1]); w.y = cvt_pk_bf16(ov[2], ov[3]); w.z = cvt_pk_bf16(ov[4], ov[5]); w.w = cvt_pk_bf16(ov[6], ov[7]);
                    *(u32x4*)(O + r * ldo + col0 + bj * HALF) = w;
                }
        }
    }
};
template <class Epi, class Sched, bool ALIGN_EPI = false, bool SP2 = false>
__device__ __forceinline__ void gemm_phase(PG8_LAS unsigned char* lds, const Gemm g, const Sched& S, const Epi& E) {
    int tid_ = threadIdx.x; asm volatile("" : "+v"(tid_));
    const int tid = tid_, wid = __builtin_amdgcn_readfirstlane(tid >> 6), lane = tid & 63, wr = wid >> 2, wc = wid & 3, fr = lane & 15, fq = lane >> 4;
    const int K = g.K, nt = K / BK;
    unsigned voffA[2], voffB[2];
#pragma unroll
    for (int i = 0; i < 2; ++i) { int R, C; stage_rc(tid * 16 + i * 8192, R, C); const int Rb = Epi::PERM ? ((R & ~31) + perm32(R & 31)) : R;
        voffA[i] = (unsigned)(R * K + C) * 2u; voffB[i] = (unsigned)(Rb * K + C) * 2u; }
    const size_t kstep = (size_t)(BK * 2);
    const size_t hstep = (size_t)HALF * K * 2;
    const size_t tstep = 2 * hstep;
    const unsigned ldsw = (unsigned)wid * 1024u;
    const int aoff = lds_byte(wr * 64 + fr, fq * 8), boff = lds_byte(wc * 32 + fr, fq * 8);
#define PG8_SA(b, h) (((b) * 2 + (h)) * HTB)
#define PG8_SB(b, h) ((4 + (b) * 2 + (h)) * HTB)
#define PG8_STAGE(bufoff, gbase, voff) do { _Pragma("unroll") for (int _i = 0; _i < 2; ++_i) \
        __builtin_amdgcn_global_load_lds((const unsigned*)((const char*)(gbase) + (voff)[_i]), (PG8_LAS unsigned*)(lds + (bufoff) + ldsw + _i * 8192), 16, 0, 0); } while (0)
#define PG8_LDA(dst, b, h) do { _Pragma("unroll") for (int m = 0; m < 4; ++m) _Pragma("unroll") for (int k = 0; k < 2; ++k) dst[m][k] = *(const PG8_LAS bf16x8*)(lds + PG8_SA(b, h) + aoff + m * 2048 + k * 1024); } while (0)
#define PG8_LDB(dst, b, h) do { _Pragma("unroll") for (int n = 0; n < 2; ++n) _Pragma("unroll") for (int k = 0; k < 2; ++k) dst[n][k] = *(const PG8_LAS bf16x8*)(lds + PG8_SB(b, h) + boff + n * 2048 + k * 1024); } while (0)
#define PG8_MMA(ai, bj, At, Bt) do { __builtin_amdgcn_s_setprio(1); _Pragma("unroll") for (int m = 0; m < 4; ++m) _Pragma("unroll") for (int n = 0; n < 2; ++n) _Pragma("unroll") for (int k = 0; k < 2; ++k) \
        acc[ai][bj][m][n] = __builtin_amdgcn_mfma_f32_16x16x32_bf16(Bt[n][k], At[m][k], acc[ai][bj][m][n], 0, 0, 0); __builtin_amdgcn_s_setprio(0); } while (0)
#define PG8_WAIT_V(n) asm volatile("s_waitcnt vmcnt(" #n ")" ::: "memory")
#define PG8_WAIT_L(n) asm volatile("s_waitcnt lgkmcnt(" #n ")" ::: "memory")
#define PG8_BAR __builtin_amdgcn_s_barrier()
#define PG8_SCHED __builtin_amdgcn_sched_barrier(0)
    Unit cur, nxt; int ui = 0;
    if (!S.next(0, cur)) return;
    f32x4 acc[2][2][4][2];
#pragma unroll
    for (int a = 0; a < 2; ++a)
#pragma unroll
        for (int b = 0; b < 2; ++b)
#pragma unroll
            for (int m = 0; m < 4; ++m)
#pragma unroll
                for (int n = 0; n < 2; ++n) acc[a][b][m][n] = (f32x4){0.f, 0.f, 0.f, 0.f};
    bf16x8 At[4][2], B0[2][2], B1[2][2];
    const char* cA = (const char*)g.A + (size_t)cur.pm * tstep; const char* cB = (const char*)g.Bt + (size_t)cur.pn * tstep;
    S.a_ready(cur);
    if constexpr (SP2) {
        PG8_STAGE(PG8_SB(0, 0), cB, voffB); PG8_STAGE(PG8_SB(0, 1), cB + hstep, voffB); PG8_STAGE(PG8_SA(0, 0), cA, voffA); PG8_STAGE(PG8_SA(0, 1), cA + hstep, voffA);
        if (wr == 1) PG8_BAR;
        PG8_WAIT_V(2); PG8_BAR;
        PG8_STAGE(PG8_SB(1, 0), cB + kstep, voffB); PG8_STAGE(PG8_SA(1, 0), cA + kstep, voffA); PG8_STAGE(PG8_SB(1, 1), cB + hstep + kstep, voffB);
        PG8_WAIT_V(6); PG8_BAR;
    } else {
        PG8_STAGE(PG8_SB(0, 0), cB, voffB); PG8_STAGE(PG8_SA(0, 0), cA, voffA); PG8_STAGE(PG8_SB(0, 1), cB + hstep, voffB); PG8_STAGE(PG8_SA(0, 1), cA + hstep, voffA);
        if (wr == 1) PG8_BAR;
        PG8_WAIT_V(4); PG8_BAR;
        PG8_STAGE(PG8_SB(1, 0), cB + kstep, voffB); PG8_STAGE(PG8_SA(1, 0), cA + kstep, voffA); PG8_STAGE(PG8_SB(1, 1), cB + hstep + kstep, voffB);
        PG8_WAIT_V(6); PG8_BAR;
    }
    for (;;) {
        const bool has_next = S.next(ui + 1, nxt);
        const char* nA = has_next ? (const char*)g.A + (size_t)nxt.pm * tstep : cA; const char* nB = has_next ? (const char*)g.Bt + (size_t)nxt.pn * tstep : cB;
        for (int t = 0; t < nt; t += 2) {
            const bool last = (t == nt - 2);
            const char* a1 = cA + (size_t)(t + 1) * kstep;
            const char* a2 = last ? nA : cA + (size_t)(t + 2) * kstep; const char* b2 = last ? nB : cB + (size_t)(t + 2) * kstep;
            const char* a3 = a2 + kstep; const char* b3 = b2 + kstep;
            if (last && has_next) S.a_ready(nxt);
            if constexpr (SP2) {
            PG8_LDB(B0, 0, 0); PG8_LDB(B1, 0, 1); PG8_SCHED; PG8_LDA(At, 0, 0); PG8_STAGE(PG8_SA(1, 1), a1 + hstep, voffA);
            PG8_WAIT_V(8); PG8_WAIT_L(0); PG8_BAR; PG8_MMA(0, 0, At, B0); PG8_MMA(0, 1, At, B1); PG8_BAR; PG8_SCHED;
            PG8_LDA(At, 0, 1); PG8_STAGE(PG8_SB(0, 0), b2, voffB); PG8_STAGE(PG8_SB(0, 1), b2 + hstep, voffB); PG8_STAGE(PG8_SA(0, 0), a2, voffA);
            PG8_WAIT_V(8); PG8_WAIT_L(0); PG8_BAR; PG8_MMA(1, 0, At, B0); PG8_MMA(1, 1, At, B1); PG8_BAR; PG8_SCHED;
            PG8_LDB(B0, 1, 0); PG8_LDB(B1, 1, 1); PG8_SCHED; PG8_LDA(At, 1, 0); PG8_STAGE(PG8_SA(0, 1), a2 + hstep, voffA);
            PG8_WAIT_V(8); PG8_WAIT_L(0); PG8_BAR; PG8_MMA(0, 0, At, B0); PG8_MMA(0, 1, At, B1); PG8_BAR; PG8_SCHED;
            PG8_LDA(At, 1, 1); PG8_STAGE(PG8_SB(1, 0), b3, voffB); PG8_STAGE(PG8_SB(1, 1), b3 + hstep, voffB); PG8_STAGE(PG8_SA(1, 0), a3, voffA);
            PG8_WAIT_V(8); PG8_WAIT_L(0); PG8_BAR; PG8_MMA(1, 0, At, B0); PG8_MMA(1, 1, At, B1); PG8_BAR; PG8_SCHED;
            } else {
            PG8_LDB(B0, 0, 0); PG8_SCHED; PG8_LDA(At, 0, 0); PG8_STAGE(PG8_SA(1, 1), a1 + hstep, voffA);
            PG8_WAIT_L(8); PG8_BAR; PG8_WAIT_L(0); PG8_MMA(0, 0, At, B0); PG8_BAR; PG8_SCHED;
            PG8_LDB(B1, 0, 1); PG8_STAGE(PG8_SB(0, 0), b2, voffB);
            PG8_BAR; PG8_WAIT_L(0); PG8_MMA(0, 1, At, B1); PG8_BAR;
            PG8_LDA(At, 0, 1); PG8_STAGE(PG8_SA(0, 0), a2, voffA);
            PG8_BAR; PG8_WAIT_L(0); PG8_MMA(1, 0, At, B0); PG8_BAR; PG8_SCHED;
            PG8_STAGE(PG8_SB(0, 1), b2 + hstep, voffB);
            PG8_WAIT_V(6); PG8_BAR; PG8_MMA(1, 1, At, B1); PG8_BAR;
            PG8_LDB(B0, 1, 0); PG8_SCHED; PG8_LDA(At, 1, 0); PG8_STAGE(PG8_SA(0, 1), a2 + hstep, voffA);
            PG8_WAIT_L(8); PG8_BAR; PG8_WAIT_L(0); PG8_MMA(0, 0, At, B0); PG8_BAR; PG8_SCHED;
            PG8_LDB(B1, 1, 1); PG8_STAGE(PG8_SB(1, 0), b3, voffB);
            PG8_BAR; PG8_WAIT_L(0); PG8_MMA(0, 1, At, B1); PG8_BAR;
            PG8_LDA(At, 1, 1); PG8_STAGE(PG8_SA(1, 0), a3, voffA);
            PG8_BAR; PG8_WAIT_L(0); PG8_MMA(1, 0, At, B0); PG8_BAR; PG8_SCHED;
            PG8_STAGE(PG8_SB(1, 1), b3 + hstep, voffB);
            PG8_WAIT_V(6); PG8_BAR; PG8_MMA(1, 1, At, B1); PG8_BAR;
            }
        }
        if constexpr (ALIGN_EPI) { if (wr == 0) PG8_BAR; }
        if constexpr (!Epi::AFTER_DRAIN) { E(acc, cur, wr, wc, fr, fq); S.done(cur); }
        if (!has_next) break;
#pragma unroll
        for (int a = 0; a < 2; ++a)
#pragma unroll
            for (int b = 0; b < 2; ++b)
#pragma unroll
                for (int m = 0; m < 4; ++m)
#pragma unroll
                    for (int n = 0; n < 2; ++n) acc[a][b][m][n] = (f32x4){0.f, 0.f, 0.f, 0.f};
        cur = nxt; cA = nA; cB = nB; ++ui;
        if constexpr (ALIGN_EPI) { if (wr == 1) PG8_BAR; }
    }
    PG8_WAIT_V(0);
    if constexpr (!ALIGN_EPI) { if (wr == 0) PG8_BAR; }
    PG8_BAR;
    if constexpr (Epi::AFTER_DRAIN) { E.fused(acc, cur, wr, wc, fr, fq, lds, wid, lane); S.done(cur); }
#undef PG8_SA
#undef PG8_SB
#undef PG8_STAGE
#undef PG8_LDA
#undef PG8_LDB
#undef PG8_MMA
#undef PG8_WAIT_V
#undef PG8_WAIT_L
#undef PG8_BAR
#undef PG8_SCHED
}
}
#define LAS __attribute__((address_space(3)))
typedef unsigned short bf16_t;
typedef float f32x4 __attribute__((ext_vector_type(4)));
typedef float f32x16 __attribute__((ext_vector_type(16)));
typedef short bf16x8 __attribute__((ext_vector_type(8)));
typedef short s16x4 __attribute__((ext_vector_type(4)));
typedef unsigned u32x4 __attribute__((ext_vector_type(4)));
typedef unsigned u32x2 __attribute__((ext_vector_type(2)));

#define XB_TMO      128
#define XB_XCNT(j)  (256  + 64 * (j))
#define XB_XSUB(j)  (1280 + 64 * (j))
#define XB_XGEN(j)  (2304 + 64 * (j))
#define XB_TOP      3328
#define XB_TOPGEN   3392
#define XCD_BAR_WORDS 3456
#define XB_SPIN_CAP (1u << 18)

__device__ __forceinline__ unsigned xb_ld(unsigned* p)              { return __hip_atomic_load(p, __ATOMIC_RELAXED, __HIP_MEMORY_SCOPE_AGENT); }
__device__ __forceinline__ unsigned xb_add(unsigned* p, unsigned v) { return __hip_atomic_fetch_add(p, v, __ATOMIC_RELAXED, __HIP_MEMORY_SCOPE_AGENT); }
__device__ __forceinline__ unsigned xb_xcc_id() { return (unsigned)__builtin_amdgcn_s_getreg((3 << 11) | 20) & 0xFu; }
#define XB_SPIN(cond, bar) do { unsigned _sp = 0; while (cond) { __builtin_amdgcn_s_sleep(1); \
    if ((++_sp & 255u) == 0u) { if (xb_ld(&(bar)[XB_TMO])) break; if (_sp > XB_SPIN_CAP) { atomicAdd(&(bar)[XB_TMO], 1u); break; } } } } while (0)

struct XcdBarrier {
    unsigned* bar; unsigned x;
    volatile LAS unsigned* st;
};

__device__ __forceinline__ XcdBarrier xcd_barrier_post(unsigned* bar, volatile LAS unsigned* st) {
    XcdBarrier b; b.bar = bar; b.x = xb_xcc_id(); b.st = st;
    if (threadIdx.x == 0) (void)xb_add(&bar[XB_XCNT(b.x)], 1u);
    return b;
}
__device__ __forceinline__ void xcd_barrier_complete(unsigned* bar, unsigned x, unsigned& nloc, unsigned& nx) {
    const unsigned G = gridDim.x * gridDim.y * gridDim.z;
    unsigned sum, cnt, mine, sp = 0u;
    for (;;) {
        sum = 0u; cnt = 0u; mine = 0u;
#pragma unroll
        for (unsigned j = 0; j < 16; ++j) { const unsigned c = xb_ld(&bar[XB_XCNT(j)]); sum += c; cnt += (c > 0u) ? 1u : 0u; mine = (j == x) ? c : mine; }
        if (sum == G) break;
        __builtin_amdgcn_s_sleep(1);
        if ((++sp & 255u) == 0u) { if (xb_ld(&bar[XB_TMO])) break; if (sp > XB_SPIN_CAP) { atomicAdd(&bar[XB_TMO], 1u); break; } }
    }
    nloc = mine > 0u ? mine : 1u; nx = cnt > 0u ? cnt : 1u;
}

__device__ __forceinline__ void xcd_barrier(const XcdBarrier& b) {
    asm volatile("s_waitcnt vmcnt(0)" ::: "memory");
    __syncthreads();
    if (threadIdx.x == 0) {
        unsigned* bar = b.bar;
        __builtin_amdgcn_s_waitcnt(0);
        unsigned nloc = b.st[0], nx = b.st[1];
        if (nloc == 0u) { xcd_barrier_complete(bar, b.x, nloc, nx); b.st[0] = nloc; b.st[1] = nx; }
        const unsigned old = xb_add(&bar[XB_XSUB(b.x)], 1u);
        const unsigned gen = old / nloc;
        if (old + 1u == (gen + 1u) * nloc) {
            __builtin_amdgcn_fence(__ATOMIC_RELEASE, "agent");
            asm volatile("s_waitcnt vmcnt(0)" ::: "memory");
            const unsigned og = xb_add(&bar[XB_TOP], 1u);
            const unsigned tg = og / nx;
            if (og + 1u == (tg + 1u) * nx) xb_add(&bar[XB_TOPGEN], 1u);
            else XB_SPIN(xb_ld(&bar[XB_TOPGEN]) == tg, bar);
            __builtin_amdgcn_fence(__ATOMIC_ACQUIRE, "agent");
            xb_add(&bar[XB_XGEN(b.x)], 1u);
            asm volatile("s_waitcnt vmcnt(0)" ::: "memory");
        } else {
            XB_SPIN(xb_ld(&bar[XB_XGEN(b.x)]) == gen, bar);
            __builtin_amdgcn_fence(__ATOMIC_ACQUIRE, "agent");
            asm volatile("s_waitcnt vmcnt(0)" ::: "memory");
        }
    }
    __syncthreads();
}


constexpr int D = 1024, DFF = 2816;
constexpr int M_P = 8 * 4096, M_S = 32 * 2048, MT = M_P + M_S;
constexpr int ZLD0 = 1536, ZLD1 = 1280;
constexpr float RMS_EPS = 1e-6f;
constexpr float NEGBIG = -1e30f;

constexpr size_t MiB = 1u << 20;
constexpr size_t WS_BAR = 16384;
constexpr size_t WS_CTR = 0;
constexpr size_t WS_TB = 1 * MiB;
constexpr size_t WS_W1 = 2 * MiB;
constexpr size_t WS_W2 = 46 * MiB;
constexpr size_t WS_WINE = 68 * MiB;
constexpr size_t WS_WVE = 71 * MiB;
constexpr size_t WS_WGLU = 72 * MiB;
constexpr size_t WS_WOE = 73 * MiB;
constexpr size_t WS_WINO = 75 * MiB;
constexpr size_t WS_WVO = 78 * MiB;
constexpr size_t WS_WOO = 79 * MiB;
constexpr size_t WS_SSQ = 84 * MiB;
constexpr size_t WS_XN = 96 * MiB;
constexpr size_t OUT_G = 0, OUT_YB = 96 * MiB, OUT_SSQ = 192 * MiB;
constexpr size_t WS_HZ = 288 * MiB;
constexpr size_t WS_Z = WS_HZ, WS_VT = WS_HZ + 288 * MiB, WS_YF = WS_HZ + 384 * MiB;
constexpr size_t WS_MIX = 816 * MiB;
constexpr size_t WS_END = 1008 * MiB;

constexpr int LDS_BYTES = 131072 + 4096 + 4096 + 64;
constexpr int NTHREADS = 512;

struct Params { const float* in[25]; float* out; unsigned char* ws; };
#define CAS __attribute__((address_space(4)))
struct PP {
    const CAS unsigned char* ka;
    __device__ __forceinline__ const float* in(int k) const { return *(const float* const CAS*)(ka + 8 * k); }
    __device__ __forceinline__ float* out() const { return *(float* const CAS*)(ka + 8 * 25); }
    __device__ __forceinline__ unsigned char* ws() const { return *(unsigned char* const CAS*)(ka + 8 * 26); }
};

__device__ __forceinline__ unsigned f2bf(float f) { unsigned u = __builtin_bit_cast(unsigned, f); return (u + 0x7fffu + ((u >> 16) & 1u)) >> 16; }
__device__ __forceinline__ unsigned pk2(float lo, float hi) { return f2bf(lo) | (f2bf(hi) << 16); }
__device__ __forceinline__ float bflo(unsigned w) { return __uint_as_float(w << 16); }
__device__ __forceinline__ float bfhi(unsigned w) { return __uint_as_float(w & 0xffff0000u); }
__device__ __forceinline__ float wave_sum(float v) {
#pragma unroll
    for (int o = 1; o < 64; o <<= 1) v += __shfl_xor(v, o);
    return v;
}
#define LDS_WAIT() asm volatile("s_waitcnt lgkmcnt(0)" ::: "memory")
#define CFENCE() asm volatile("" ::: "memory")

__device__ __forceinline__ void tr_item(const float* W, int ldw, int K, int k0, int nsrc, bf16_t* WT, int drow, const float* gain, LAS float* scr, int lane) {
    float wv[32];
#pragma unroll
    for (int i = 0; i < 32; ++i) { const int kk = 2 * i + (lane >> 5); wv[i] = W[(size_t)(k0 + kk) * ldw + nsrc + (lane & 31)]; }
#pragma unroll
    for (int i = 0; i < 32; ++i) { const int kk = 2 * i + (lane >> 5); const float gk = gain ? gain[k0 + kk] : 1.0f; scr[kk * 33 + (lane & 31)] = wv[i] * gk; }
    LDS_WAIT();
    const int c = lane & 7;
#pragma unroll
    for (int j = 0; j < 4; ++j) { const int n = (lane >> 3) + 8 * j; const LAS float* s = scr + (8 * c) * 33 + n;
        u32x4 o; o.x = pk2(s[0 * 33], s[1 * 33]); o.y = pk2(s[2 * 33], s[3 * 33]); o.z = pk2(s[4 * 33], s[5 * 33]); o.w = pk2(s[6 * 33], s[7 * 33]);
        *(u32x4*)(WT + (size_t)(drow + n) * K + k0 + 8 * c) = o; }
    LDS_WAIT();
}
__device__ __forceinline__ void tr_job(int r, const float* W, int ldw, int K, int ncol0, int ncols, bf16_t* WT, int ilv, const float* gain, LAS float* scr, int lane) {
    const int nblk = ncols >> 5, kb = r / nblk, nb = r - kb * nblk, n0 = nb * 32;
    const int drow = ilv ? ((n0 >> 7) * 256 + (n0 & 127) + (ilv == 2 ? 128 : 0)) : n0;
    tr_item(W, ldw, K, 64 * kb, ncol0 + n0, WT, drow, gain, scr, lane);
}
__device__ __forceinline__ void prologue_weights(const PP P, LAS float* scr, int gw, int ngw, int lane) {
    unsigned char* ws = P.ws();
    constexpr int I_F = 1408;
    constexpr int N_FFN = 12 * I_F;
    constexpr int I_INE = 16 * 48, I_VE = 16 * 16, I_GLU = 8 * 16, I_OE = 16 * 32, I_INO = 16 * 40, I_VO = 16 * 8, I_OO = 16 * 32;
    constexpr int NITEMS = N_FFN + I_INE + I_VE + I_GLU + I_OE + I_INO + I_VO + I_OO;
    for (int it = gw; it < NITEMS; it += ngw) {
        int r = it;
        if (r < N_FFN) {
            const int f = r / (3 * I_F); int rr = r - f * 3 * I_F; const int which = rr / I_F; rr -= which * I_F;
            if (which == 0)      tr_job(rr, P.in(3) + (size_t)f * D * DFF, DFF, D, 0, DFF, (bf16_t*)(ws + WS_W1) + (size_t)f * 2 * DFF * D, 1, P.in(2) + f * D, scr, lane);
            else if (which == 1) tr_job(rr, P.in(4) + (size_t)f * D * DFF, DFF, D, 0, DFF, (bf16_t*)(ws + WS_W1) + (size_t)f * 2 * DFF * D, 2, P.in(2) + f * D, scr, lane);
            else                 tr_job(rr, P.in(5) + (size_t)f * DFF * D, D, DFF, 0, D, (bf16_t*)(ws + WS_W2) + (size_t)f * D * DFF, 0, nullptr, scr, lane);
            continue;
        }
        r -= N_FFN;
        if (r < I_INE) { tr_job(r, P.in(7), 2048, D, 0, 1536, (bf16_t*)(ws + WS_WINE), 0, P.in(6), scr, lane); continue; } r -= I_INE;
        if (r < I_VE)  { tr_job(r, P.in(7), 2048, D, 1536, 512, (bf16_t*)(ws + WS_WVE), 0, P.in(6), scr, lane); continue; } r -= I_VE;
        if (r < I_GLU) { tr_job(r, P.in(16), 512, 512, 0, 512, (bf16_t*)(ws + WS_WGLU), 0, nullptr, scr, lane); continue; } r -= I_GLU;
        if (r < I_OE)  { tr_job(r, P.in(19), D, D, 0, D, (bf16_t*)(ws + WS_WOE), 0, nullptr, scr, lane); continue; } r -= I_OE;
        if (r < I_INO) { tr_job(r, P.in(20), 1536, D, 0, 1280, (bf16_t*)(ws + WS_WINO), 0, P.in(6) + D, scr, lane); continue; } r -= I_INO;
        if (r < I_VO)  { tr_job(r, P.in(20), 1536, D, 1280, 256, (bf16_t*)(ws + WS_WVO), 0, P.in(6) + D, scr, lane); continue; } r -= I_VO;
        tr_job(r, P.in(22), D, D, 0, D, (bf16_t*)(ws + WS_WOO), 0, nullptr, scr, lane);
    }
}
__device__ __forceinline__ int t5_bucket(int rel) {
    const int n = rel < 0 ? -rel : rel;
    int b;
    if (n < 8) b = n;
    else { b = 8 + (n >= 12) + (n >= 16) + (n >= 23) + (n >= 32) + (n >= 46) + (n >= 64) + (n >= 91) + (n >= 128); if (b > 15) b = 15; }
    return b + (rel > 0 ? 16 : 0);
}
__device__ __forceinline__ void prologue_tables(const PP P, int tid) {
    if (blockIdx.x == 0) {
        float* tb = (float*)(P.ws() + WS_TB);
        for (int i = tid; i < 16 * 257; i += NTHREADS) { const int h = i / 257, ri = i - h * 257; tb[i] = P.in(23)[t5_bucket(ri - 128) * 16 + h]; }
    }
}

__device__ __forceinline__ void rms_pass(const PP P, const float* gain, int mode, int gw, int ngw, int lane) {
    bf16_t* XN = (bf16_t*)(P.ws() + WS_XN);
    if (mode == 0) {
        for (int m0 = gw; m0 < MT; m0 += 4 * ngw) {
            f32x4 v[4][4];
#pragma unroll
            for (int rr = 0; rr < 4; ++rr) { const int m = m0 + rr * ngw < MT ? m0 + rr * ngw : m0;
                const float* src = m < M_P ? P.in(0) + (size_t)m * D : P.in(1) + (size_t)(m - M_P) * D;
                const f32x4* xr = (const f32x4*)src + lane;
#pragma unroll
                for (int j = 0; j < 4; ++j) v[rr][j] = xr[64 * j]; }
#pragma unroll
            for (int rr = 0; rr < 4; ++rr) { const int m = m0 + rr * ngw; if (m >= MT) break;
                float ss = 0.f;
#pragma unroll
                for (int j = 0; j < 4; ++j) ss += (v[rr][j].x * v[rr][j].x + v[rr][j].y * v[rr][j].y) + (v[rr][j].z * v[rr][j].z + v[rr][j].w * v[rr][j].w);
                const float sst = wave_sum(ss);
                if (lane < 16) ((float*)((unsigned char*)P.out() + OUT_SSQ))[(size_t)m * 16 + lane] = lane == 0 ? sst : 0.f;
                u32x2* o8 = (u32x2*)(XN + (size_t)m * D) + lane;
#pragma unroll
                for (int j = 0; j < 4; ++j) { u32x2 w; w.x = pk2(v[rr][j].x, v[rr][j].y); w.y = pk2(v[rr][j].z, v[rr][j].w); o8[64 * j] = w; } }
        }
    } else {
        f32x4 gv[4];
#pragma unroll
        for (int j = 0; j < 4; ++j) gv[j] = ((const f32x4*)gain)[lane + 64 * j];
        for (int m0 = gw; m0 < MT; m0 += 4 * ngw) {
            u32x2 w[4][4];
#pragma unroll
            for (int rr = 0; rr < 4; ++rr) { const int m = m0 + rr * ngw < MT ? m0 + rr * ngw : m0; const u32x2* xr = (const u32x2*)(XN + (size_t)m * D) + lane;
#pragma unroll
                for (int j = 0; j < 4; ++j) w[rr][j] = xr[64 * j]; }
#pragma unroll
            for (int rr = 0; rr < 4; ++rr) { const int m = m0 + rr * ngw; if (m >= MT) break;
                f32x4 v[4]; float ss = 0.f;
#pragma unroll
                for (int j = 0; j < 4; ++j) { v[j] = (f32x4){bflo(w[rr][j].x), bfhi(w[rr][j].x), bflo(w[rr][j].y), bfhi(w[rr][j].y)}; ss += (v[j].x * v[j].x + v[j].y * v[j].y) + (v[j].z * v[j].z + v[j].w * v[j].w); }
                const float rstd = 1.0f / sqrtf(wave_sum(ss) * (1.0f / D) + RMS_EPS);
                f32x4* xo = (f32x4*)(P.out() + (size_t)m * D) + lane;
#pragma unroll
                for (int j = 0; j < 4; ++j) __builtin_nontemporal_store(v[j] * rstd * gv[j], xo + 64 * j); }
        }
    }
}

__device__ __forceinline__ int crow(int i, int hi) { return (i & 3) + 8 * (i >> 2) + 4 * hi; }
#define MFMA32(a, b, c) __builtin_amdgcn_mfma_f32_32x32x16_bf16((a), (b), (c), 0, 0, 0)
typedef float f32x2_t __attribute__((ext_vector_type(2))); typedef __bf16 bf16x2_t __attribute__((ext_vector_type(2)));
__device__ __forceinline__ unsigned cvtpk_s(float lo, float hi) { f32x2_t v = {lo, hi}; bf16x2_t r = __builtin_convertvector(v, bf16x2_t); return __builtin_bit_cast(unsigned, r); }
constexpr int SST_PITCH = 272;
constexpr int SST_BYTES = 16 * SST_PITCH;
__device__ __forceinline__ unsigned cvtpk(float lo, float hi) { unsigned r; asm volatile("v_cvt_pk_bf16_f32 %0, %1, %2" : "=v"(r) : "v"(lo), "v"(hi)); return r; }
template <int DIR> __device__ __forceinline__ void s5_task2(const PP P, int sA, int sB, int g, LAS unsigned char* wl, int lane) {
    constexpr int dir = DIR;
    const int pl = lane & 31, h = lane >> 5;
    const int L = sA < 8 ? 4096 : 2048;
    const size_t rowA = sA < 8 ? (size_t)sA * 4096 : (size_t)M_P + (size_t)(sA - 8) * 2048;
    const size_t rowB = sB < 8 ? (size_t)sB * 4096 : (size_t)M_P + (size_t)(sB - 8) * 2048;
    const int dg = dir * 32 + g;
    const bf16_t* Z = (const bf16_t*)(P.ws() + WS_Z);
    bf16_t* Y = dir ? (bf16_t*)((unsigned char*)P.out() + OUT_YB) : (bf16_t*)(P.ws() + WS_YF);
    float are[2], aim[2];
    bf16x8 bfr[4];
#pragma unroll
    for (int st = 0; st < 2; ++st) {
        const int p = st * 32 + pl;
        const float lre = P.in(8)[dg * 64 + p], lim = P.in(9)[dg * 64 + p], dt = expf(P.in(10)[dg]);
        const float xr = lre * dt, th = lim * dt;
        const float mag = expf(xr), em1 = expm1f(xr), sn = sinf(th), cs_ = cosf(th), sh = sinf(0.5f * th);
        const float abr = mag * cs_, abi = mag * sn;
        const float nr = em1 * cs_ - 2.0f * sh * sh;
        const float den = lre * lre + lim * lim;
        const float cr = (nr * lre + abi * lim) / den, ci = (abi * lre - nr * lim) / den;
        are[st] = abr; aim[st] = abi;
        const float* br = P.in(11) + (size_t)(dg * 64 + p) * 16 + 8 * h;
        const float* bi = P.in(12) + (size_t)(dg * 64 + p) * 16 + 8 * h;
        const f32x4 r0 = *(const f32x4*)br, r1 = *(const f32x4*)(br + 4), i0 = *(const f32x4*)bi, i1 = *(const f32x4*)(bi + 4);
        float vr[8], vi[8];
#pragma unroll
        for (int j = 0; j < 4; ++j) {
            vr[j] = cr * r0[j] - ci * i0[j]; vi[j] = cr * i0[j] + ci * r0[j];
            vr[4 + j] = cr * r1[j] - ci * i1[j]; vi[4 + j] = cr * i1[j] + ci * r1[j];
        }
        u32x4 wr_, wi_;
        wr_.x = pk2(vr[0], vr[1]); wr_.y = pk2(vr[2], vr[3]); wr_.z = pk2(vr[4], vr[5]); wr_.w = pk2(vr[6], vr[7]);
        wi_.x = pk2(vi[0], vi[1]); wi_.y = pk2(vi[2], vi[3]); wi_.z = pk2(vi[4], vi[5]); wi_.w = pk2(vi[6], vi[7]);
        bfr[2 * st] = __builtin_bit_cast(bf16x8, wr_); bfr[2 * st + 1] = __builtin_bit_cast(bf16x8, wi_);
    }
    const int cc = lane & 15, q = lane >> 4;
    bf16x8 cf[4];
#pragma unroll
    for (int kb = 0; kb < 4; ++kb) {
        float v[8];
#pragma unroll
        for (int j = 0; j < 8; ++j) {
            const int kp = kb * 32 + q * 8 + j, plp = kp >> 2, part = kp & 3, p = (part >> 1) * 32 + plp;
            const size_t ci_ = (size_t)(dg * 16 + cc) * 64 + p;
            v[j] = (part & 1) ? -P.in(14)[ci_] : P.in(13)[ci_];
        }
        u32x4 w; w.x = pk2(v[0], v[1]); w.y = pk2(v[2], v[3]); w.z = pk2(v[4], v[5]); w.w = pk2(v[6], v[7]);
        cf[kb] = __builtin_bit_cast(bf16x8, w);
    }
    float sre0 = 0.f, sim0 = 0.f, sre1 = 0.f, sim1 = 0.f;
    const int nblk = L / 16;
    const int ar = lane & 31, ahr = (ar >> 2) & 1, ai_ = (ar & 3) + 4 * (ar >> 3), atau = dir ? 15 - ai_ : ai_;
    const bf16_t* ubase = Z + ((ahr ? rowB : rowA) + atau) * ZLD0 + g * 16 + 8 * h;
    bf16x8 unext[4];
#pragma unroll
    for (int k = 0; k < 4; ++k) { const int tb_ = dir ? (nblk - 1 - k) * 16 : k * 16; unext[k] = *(const bf16x8*)(ubase + (size_t)tb_ * ZLD0); }
    LAS unsigned char* sst = wl + h * SST_BYTES;
    const size_t rowH = h ? rowB : rowA;
    for (int blk4 = 0; blk4 < nblk; blk4 += 4) {
        bf16x8 ucur4[4];
#pragma unroll
        for (int k = 0; k < 4; ++k) ucur4[k] = unext[k];
        if (blk4 + 4 < nblk) {
#pragma unroll
            for (int k = 0; k < 4; ++k) { const int bn = blk4 + 4 + k; const int tb_ = dir ? (nblk - 1 - bn) * 16 : bn * 16; unext[k] = *(const bf16x8*)(ubase + (size_t)tb_ * ZLD0); }
        }
#pragma unroll
        for (int k = 0; k < 4; ++k) {
        const int blk = blk4 + k;
        const int tb = dir ? (nblk - 1 - blk) * 16 : blk * 16;
        const bf16x8 ucur = ucur4[k];
        f32x16 bu0 = {}, bu1 = {}, bu2 = {}, bu3 = {};
        bu0 = MFMA32(ucur, bfr[0], bu0); bu1 = MFMA32(ucur, bfr[1], bu1); bu2 = MFMA32(ucur, bfr[2], bu2); bu3 = MFMA32(ucur, bfr[3], bu3);
#pragma unroll
        for (int i = 0; i < 16; ++i) {
            const float n0r = fmaf(are[0], sre0, fmaf(-aim[0], sim0, bu0[i])), n0i = fmaf(are[0], sim0, fmaf(aim[0], sre0, bu1[i]));
            sre0 = n0r; sim0 = n0i;
            asm volatile("" : "+v"(sre0), "+v"(sim0));
            const float n1r = fmaf(are[1], sre1, fmaf(-aim[1], sim1, bu2[i])), n1i = fmaf(are[1], sim1, fmaf(aim[1], sre1, bu3[i]));
            sre1 = n1r; sim1 = n1i;
            asm volatile("" : "+v"(sre1), "+v"(sim1));
            const int tau = dir ? 15 - i : i;
            u32x2 w; w.x = cvtpk_s(sre0, sim0); w.y = cvtpk_s(sre1, sim1);
            *(LAS u32x2*)(sst + tau * SST_PITCH + pl * 8) = w;
        }
        CFENCE();
#pragma unroll
        for (int sq = 0; sq < 2; ++sq) {
            f32x4 acc = {0.f, 0.f, 0.f, 0.f};
#pragma unroll
            for (int kb = 0; kb < 4; ++kb) {
                const bf16x8 a = *(const LAS bf16x8*)(wl + sq * SST_BYTES + cc * SST_PITCH + (kb * 32 + q * 8) * 2);
                acc = __builtin_amdgcn_mfma_f32_16x16x32_bf16(cf[kb], a, acc, 0, 0, 0);
            }
            bf16_t* yp = Y + ((sq ? rowB : rowA) + tb + cc) * 512 + g * 16 + q * 4;
            u32x2 yw; yw.x = cvtpk_s(acc[0], acc[1]); yw.y = cvtpk_s(acc[2], acc[3]);
            *(u32x2*)yp = yw;
        }
        CFENCE();
        }
    }
    (void)rowH;
}
__device__ __forceinline__ void s5_combine(const PP P, int gtid, int ngt) {
    const bf16_t* Z = (const bf16_t*)(P.ws() + WS_Z); const bf16_t* YF = (const bf16_t*)(P.ws() + WS_YF); const bf16_t* YB = (const bf16_t*)((unsigned char*)P.out() + OUT_YB);
    bf16_t* G = (bf16_t*)((unsigned char*)P.out() + OUT_G);
    const float* Dk = P.in(15);
    for (int e0 = gtid; e0 < MT * 64; e0 += 4 * ngt) {
        u32x4 uw2[4], fw2[4], bw2[4];
#pragma unroll
        for (int rr = 0; rr < 4; ++rr) { const int e = e0 + rr * ngt < MT * 64 ? e0 + rr * ngt : e0; const int m = e >> 6, c8 = (e & 63) * 8;
            uw2[rr] = *(const u32x4*)(Z + (size_t)m * ZLD0 + c8); fw2[rr] = *(const u32x4*)(YF + (size_t)m * 512 + c8); bw2[rr] = *(const u32x4*)(YB + (size_t)m * 512 + c8); }
#pragma unroll
        for (int rr = 0; rr < 4; ++rr) {
        const int e = e0 + rr * ngt; if (e >= MT * 64) break;
        const int m = e >> 6, c8 = (e & 63) * 8;
        const u32x4 uw = uw2[rr], fw = fw2[rr], bw = bw2[rr];
        const f32x4 d0 = *(const f32x4*)(Dk + c8), d1 = *(const f32x4*)(Dk + c8 + 4);
        float y[8];
        y[0] = d0.x * bflo(uw.x) + bflo(fw.x) + bflo(bw.x); y[1] = d0.y * bfhi(uw.x) + bfhi(fw.x) + bfhi(bw.x);
        y[2] = d0.z * bflo(uw.y) + bflo(fw.y) + bflo(bw.y); y[3] = d0.w * bfhi(uw.y) + bfhi(fw.y) + bfhi(bw.y);
        y[4] = d1.x * bflo(uw.z) + bflo(fw.z) + bflo(bw.z); y[5] = d1.y * bfhi(uw.z) + bfhi(fw.z) + bfhi(bw.z);
        y[6] = d1.z * bflo(uw.w) + bflo(fw.w) + bflo(bw.w); y[7] = d1.w * bfhi(uw.w) + bfhi(fw.w) + bfhi(bw.w);
#pragma unroll
        for (int j = 0; j < 8; ++j) { const float v = y[j], t = 0.7978845608028654f * (v + 0.044715f * v * v * v); y[j] = v * __builtin_amdgcn_rcpf(1.0f + __expf(-2.0f * t)); }
        u32x4 w; w.x = pk2(y[0], y[1]); w.y = pk2(y[2], y[3]); w.z = pk2(y[4], y[5]); w.w = pk2(y[6], y[7]);
        *(u32x4*)(G + (size_t)m * 512 + c8) = w;
        }
    }
}

__device__ __forceinline__ void softmax_pv(f32x16& sc, float& m, float& l, f32x16& o0, f32x16& o1, const s16x4 (&v)[2][2][2]) {
    float tm = sc[0];
#pragma unroll
    for (int i = 1; i < 16; ++i) tm = fmaxf(tm, sc[i]);
    tm = fmaxf(tm, __shfl_xor(tm, 32));
    const float mn = fmaxf(m, tm), alpha = __expf(m - mn);
    float ps = 0.f;
#pragma unroll
    for (int i = 0; i < 16; ++i) { const float pv = sc[i] > -1e29f ? __expf(sc[i] - mn) : 0.f; sc[i] = pv; ps += pv; }
    l = l * alpha + ps; m = mn;
#pragma unroll
    for (int i = 0; i < 16; ++i) { o0[i] *= alpha; o1[i] *= alpha; }
    u32x4 w0, w1;
    w0.x = pk2(sc[0], sc[1]); w0.y = pk2(sc[2], sc[3]); w0.z = pk2(sc[4], sc[5]); w0.w = pk2(sc[6], sc[7]);
    w1.x = pk2(sc[8], sc[9]); w1.y = pk2(sc[10], sc[11]); w1.z = pk2(sc[12], sc[13]); w1.w = pk2(sc[14], sc[15]);
    const bf16x8 pf0 = __builtin_bit_cast(bf16x8, w0), pf1 = __builtin_bit_cast(bf16x8, w1);
#define VFR(dh, s) (bf16x8){v[dh][s][0][0], v[dh][s][0][1], v[dh][s][0][2], v[dh][s][0][3], v[dh][s][1][0], v[dh][s][1][1], v[dh][s][1][2], v[dh][s][1][3]}
    o0 = MFMA32(VFR(0, 0), pf0, o0); o0 = MFMA32(VFR(0, 1), pf1, o0);
    o1 = MFMA32(VFR(1, 0), pf0, o1); o1 = MFMA32(VFR(1, 1), pf1, o1);
#undef VFR
}
__device__ __forceinline__ void attn_store(bf16_t* op  , const f32x16& o0, const f32x16& o1, float inv) {
#pragma unroll
    for (int a = 0; a < 4; ++a) {
        u32x2 w; w.x = pk2(o0[4 * a] * inv, o0[4 * a + 1] * inv); w.y = pk2(o0[4 * a + 2] * inv, o0[4 * a + 3] * inv); *(u32x2*)(op + 8 * a) = w;
        u32x2 x; x.x = pk2(o1[4 * a] * inv, o1[4 * a + 1] * inv); x.y = pk2(o1[4 * a + 2] * inv, o1[4 * a + 3] * inv); *(u32x2*)(op + 32 + 8 * a) = x;
    }
}
__device__ __forceinline__ void gqa_task(const PP P, int idx, LAS float* tbl, int lane) {
    const int hh = idx & 3, kvg = (idx >> 2) & 3, tb32 = idx >> 4, head = kvg * 4 + hh;
    const int m0 = tb32 * 32;
    int row0, L; if (m0 < M_P) { row0 = m0 & ~4095; L = 4096; } else { row0 = M_P + ((m0 - M_P) & ~2047); L = 2048; }
    const int qpos0 = m0 - row0, r32 = lane & 31, hi = lane >> 5;
    const bf16_t* Z = (const bf16_t*)(P.ws() + WS_Z); const bf16_t* VT = (const bf16_t*)(P.ws() + WS_VT); bf16_t* MIX = (bf16_t*)(P.ws() + WS_MIX);
    const float* tbg = (const float*)(P.ws() + WS_TB) + head * 257;
    for (int i = lane; i < 257; i += 64) tbl[i] = tbg[i];
    const bf16_t* qp = Z + (size_t)(m0 + r32) * ZLD1 + head * 64 + hi * 8;
    bf16x8 qr[4];
#pragma unroll
    for (int ds = 0; ds < 4; ++ds) qr[ds] = *(const bf16x8*)(qp + ds * 16);
    float m = P.in(21)[head], l = hi ? 0.f : 1.f;
    f32x16 o0 = {}, o1 = {};
    const int qpos = qpos0 + r32;
    for (int kt = 0; kt < 9; ++kt) {
        const int kp0 = qpos0 - 128 + kt * 32;
        if (kp0 < 0 || kp0 >= L) continue;
        const bf16_t* kptr = Z + (size_t)(row0 + kp0 + r32) * ZLD1 + 1024 + kvg * 64 + hi * 8;
        bf16x8 kf[4];
#pragma unroll
        for (int ds = 0; ds < 4; ++ds) kf[ds] = *(const bf16x8*)(kptr + ds * 16);
        const bf16_t* vptr = VT + (size_t)(kvg * 64 + r32) * MT + row0 + kp0 + hi * 4;
        s16x4 v[2][2][2];
#pragma unroll
        for (int dh = 0; dh < 2; ++dh)
#pragma unroll
            for (int s = 0; s < 2; ++s) { v[dh][s][0] = *(const s16x4*)(vptr + (size_t)dh * 32 * MT + s * 16); v[dh][s][1] = *(const s16x4*)(vptr + (size_t)dh * 32 * MT + s * 16 + 8); }
        f32x16 sc = {};
#pragma unroll
        for (int ds = 0; ds < 4; ++ds) sc = MFMA32(kf[ds], qr[ds], sc);
#pragma unroll
        for (int i = 0; i < 16; ++i) {
            const int rel = kp0 + crow(i, hi) - qpos;
            const bool valid = rel >= -128 && rel <= 128;
            const int ri = (rel < -128 ? -128 : (rel > 128 ? 128 : rel)) + 128;
            const float b = tbl[ri];
            sc[i] = valid ? sc[i] * 0.125f + b : NEGBIG;
        }
        softmax_pv(sc, m, l, o0, o1, v);
    }
    l += __shfl_xor(l, 32);
    attn_store(MIX + (size_t)(m0 + r32) * D + head * 64 + 4 * hi, o0, o1, 1.0f / l);
}
constexpr float LOG2E = 1.4426950408889634f;
__device__ __forceinline__ void softmax2_pv(f32x16& sc, float& m, float& l, f32x16& o0, f32x16& o1, const bf16x8 (&vf)[2][2]) {
    float tm = fmaxf(fmaxf(sc[0], sc[1]), fmaxf(sc[2], sc[3]));
#pragma unroll
    for (int i = 4; i < 16; i += 4) tm = fmaxf(tm, fmaxf(fmaxf(sc[i], sc[i + 1]), fmaxf(sc[i + 2], sc[i + 3])));
    tm = fmaxf(tm, __shfl_xor(tm, 32));
    const float mn = fmaxf(m, tm);
    if (__builtin_amdgcn_ballot_w64(mn > m)) {
        const float alpha = __builtin_amdgcn_exp2f(m - mn);
        l *= alpha;
#pragma unroll
        for (int i = 0; i < 16; ++i) { o0[i] *= alpha; o1[i] *= alpha; }
        m = mn;
    }
    float ps = 0.f;
#pragma unroll
    for (int i = 0; i < 16; ++i) { const float pv = __builtin_amdgcn_exp2f(sc[i] - m); sc[i] = pv; ps += pv; }
    l += ps;
    u32x4 w0, w1;
    w0.x = cvtpk_s(sc[0], sc[1]); w0.y = cvtpk_s(sc[2], sc[3]); w0.z = cvtpk_s(sc[4], sc[5]); w0.w = cvtpk_s(sc[6], sc[7]);
    w1.x = cvtpk_s(sc[8], sc[9]); w1.y = cvtpk_s(sc[10], sc[11]); w1.z = cvtpk_s(sc[12], sc[13]); w1.w = cvtpk_s(sc[14], sc[15]);
    const bf16x8 pf0 = __builtin_bit_cast(bf16x8, w0), pf1 = __builtin_bit_cast(bf16x8, w1);
    o0 = MFMA32(vf[0][0], pf0, o0); o0 = MFMA32(vf[0][1], pf1, o0);
    o1 = MFMA32(vf[1][0], pf0, o1); o1 = MFMA32(vf[1][1], pf1, o1);
}
constexpr int GK_PITCH = 144, GV_PITCH = 776, GQ_K = 0, GQ_V = 384 * GK_PITCH, GQ_TBL = GQ_V + 64 * GV_PITCH, GQ_TBL_W = 1040;
static_assert(GQ_TBL + 8 * GQ_TBL_W <= 131072, "gqa lds");
__device__ __forceinline__ void gqa_phase(const PP P, LAS unsigned char* lds, int tid, int cb, int G) {
    const int lane = tid & 63, wave = __builtin_amdgcn_readfirstlane(tid >> 6), r32 = lane & 31, hi = lane >> 5;
    const bf16_t* Z = (const bf16_t*)(P.ws() + WS_Z); const bf16_t* VT = (const bf16_t*)(P.ws() + WS_VT); bf16_t* MIX = (bf16_t*)(P.ws() + WS_MIX);
    LAS float* tbl = (LAS float*)(lds + GQ_TBL + wave * GQ_TBL_W);
    u32x4 kreg[6], vreg[6];
#define GQA_LOAD(unit_) do { const int kvg_ = (unit_) & 3, m0_ = ((unit_) >> 2) * 128; int row0_, L_; if (m0_ < M_P) { row0_ = m0_ & ~4095; L_ = 4096; } else { row0_ = M_P + ((m0_ - M_P) & ~2047); L_ = 2048; } \
        const int kb_ = m0_ - 128;     \
        _Pragma("unroll") for (int c = 0; c < 6; ++c) { const int id = tid + 512 * c, row = id >> 3, ch = id & 7, tok = kb_ + row; const bool ok = tok >= row0_ && tok < row0_ + L_; \
            kreg[c] = ok ? *(const u32x4*)(Z + (size_t)tok * ZLD1 + 1024 + kvg_ * 64 + ch * 8) : (u32x4){0u, 0u, 0u, 0u}; } \
        _Pragma("unroll") for (int c = 0; c < 6; ++c) { const int id = tid + 512 * c, d = id / 48, ch = id - d * 48, tok = kb_ + ch * 8; const bool ok = tok >= row0_ && tok < row0_ + L_; \
            vreg[c] = ok ? *(const u32x4*)(VT + (size_t)(kvg_ * 64 + d) * MT + tok) : (u32x4){0u, 0u, 0u, 0u}; } } while (0)
    int unit = cb;
    if (unit < 3072) GQA_LOAD(unit);
    for (; unit < 3072; unit += G) {
        __syncthreads();
#pragma unroll
        for (int c = 0; c < 6; ++c) { const int id = tid + 512 * c, row = id >> 3, ch = id & 7; *(LAS u32x4*)(lds + GQ_K + row * GK_PITCH + ch * 16) = kreg[c]; }
#pragma unroll
        for (int c = 0; c < 6; ++c) { const int id = tid + 512 * c, d = id / 48, ch = id - d * 48; LAS u32x2* vp = (LAS u32x2*)(lds + GQ_V + d * GV_PITCH + ch * 16);
            vp[0] = (u32x2){vreg[c].x, vreg[c].y}; vp[1] = (u32x2){vreg[c].z, vreg[c].w}; }
        const int kvg = unit & 3, m0 = (unit >> 2) * 128;
        int row0, L; if (m0 < M_P) { row0 = m0 & ~4095; L = 4096; } else { row0 = M_P + ((m0 - M_P) & ~2047); L = 2048; }
        const int head = kvg * 4 + (wave >> 1);
        { const float* tbg = (const float*)(P.ws() + WS_TB) + head * 257; for (int i = lane; i < 257; i += 64) tbl[i] = tbg[i] * LOG2E; }
        if (unit + G < 3072) GQA_LOAD(unit + G);
        __syncthreads();
        const float sink2 = P.in(21)[head] * LOG2E;
        for (int sub = 0; sub < 2; ++sub) {
            const int qoff = ((wave & 1) * 2 + sub) * 32;
            const bf16_t* qp = Z + (size_t)(m0 + qoff + r32) * ZLD1 + head * 64 + hi * 8;
            bf16x8 qr[4];
#pragma unroll
            for (int ds = 0; ds < 4; ++ds) qr[ds] = *(const bf16x8*)(qp + ds * 16);
            float m = sink2, l = hi ? 0.f : 1.f;
            f32x16 o0 = {}, o1 = {};
            for (int t = 0; t < 9; ++t) {
                const int kr0 = qoff + 32 * t, tok0 = m0 - 128 + kr0;
                if (tok0 < row0 || tok0 >= row0 + L) continue;
                bf16x8 kf[4];
#pragma unroll
                for (int ds = 0; ds < 4; ++ds) kf[ds] = *(const LAS bf16x8*)(lds + GQ_K + (kr0 + r32) * GK_PITCH + (16 * ds + 8 * hi) * 2);
                bf16x8 vf[2][2];
#pragma unroll
                for (int dh = 0; dh < 2; ++dh)
#pragma unroll
                    for (int s = 0; s < 2; ++s) { const LAS s16x4* vp = (const LAS s16x4*)(lds + GQ_V + (dh * 32 + r32) * GV_PITCH + (kr0 + 16 * s + 4 * hi) * 2);
                        const s16x4 a = vp[0], c2 = vp[2]; vf[dh][s] = (bf16x8){a[0], a[1], a[2], a[3], c2[0], c2[1], c2[2], c2[3]}; }
                f32x16 sc = {};
#pragma unroll
                for (int ds = 0; ds < 4; ++ds) sc = MFMA32(kf[ds], qr[ds], sc);
                const int ib = 32 * t - r32 + 4 * hi;
                if (t == 0 || t == 8) {
#pragma unroll
                    for (int i = 0; i < 16; ++i) { const int ix = ib + (i & 3) + 8 * (i >> 2); const bool valid = ix >= 0 && ix <= 256; const float bb = tbl[valid ? ix : 0];
                        sc[i] = valid ? sc[i] * (0.125f * LOG2E) + bb : NEGBIG; }
                } else {
#pragma unroll
                    for (int i = 0; i < 16; ++i) sc[i] = sc[i] * (0.125f * LOG2E) + tbl[ib + (i & 3) + 8 * (i >> 2)];
                }
                softmax2_pv(sc, m, l, o0, o1, vf);
            }
            l += __shfl_xor(l, 32);
            attn_store(MIX + (size_t)(m0 + qoff + r32) * D + head * 64 + 4 * hi, o0, o1, 1.0f / l);
        }
    }
#undef GQA_LOAD
}
__device__ __forceinline__ void na_task(const PP P, int idx, LAS float* tbl, int lane) {
    const int qh = idx & 1, h = (idx >> 1) & 7, R = idx >> 4;
    int r, rows, row0;
    if (R < 512) { r = R & 63; rows = 64; row0 = (R >> 6) * 4096; } else { const int R2 = R - 512; r = R2 & 31; rows = 32; row0 = M_P + (R2 >> 5) * 2048; }
    int rs = r - 4; rs = rs < 0 ? 0 : (rs > rows - 8 ? rows - 8 : rs);
    const int r32 = lane & 31, hi = lane >> 5;
    const int m0 = row0 + r * 64 + qh * 32, cq = qh * 32 + r32;
    int cs = cq - 8; cs = cs < 0 ? 0 : (cs > 48 ? 48 : cs);
    const int kbase = row0 + rs * 64;
    const bf16_t* Z = (const bf16_t*)(P.ws() + WS_Z); const bf16_t* VT = (const bf16_t*)(P.ws() + WS_VT); bf16_t* MIX = (bf16_t*)(P.ws() + WS_MIX);
    const float* rpb = P.in(18) + h * 465;
    for (int i = lane; i < 465; i += 64) tbl[i] = rpb[i];
    const bf16_t* qp = Z + (size_t)(m0 + r32) * ZLD0 + 512 + h * 64 + hi * 8;
    bf16x8 qr[4];
#pragma unroll
    for (int ds = 0; ds < 4; ++ds) qr[ds] = *(const bf16x8*)(qp + ds * 16);
    float m = NEGBIG, l = 0.f;
    f32x16 o0 = {}, o1 = {};
    for (int kt = 0; kt < 16; ++kt) {
        const int kt0 = kbase + kt * 32;
        const bf16_t* kptr = Z + (size_t)(kt0 + r32) * ZLD0 + 1024 + h * 64 + hi * 8;
        bf16x8 kf[4];
#pragma unroll
        for (int ds = 0; ds < 4; ++ds) kf[ds] = *(const bf16x8*)(kptr + ds * 16);
        const bf16_t* vptr = VT + (size_t)(h * 64 + r32) * MT + kt0 + hi * 4;
        s16x4 v[2][2][2];
#pragma unroll
        for (int dh = 0; dh < 2; ++dh)
#pragma unroll
            for (int s = 0; s < 2; ++s) { v[dh][s][0] = *(const s16x4*)(vptr + (size_t)dh * 32 * MT + s * 16); v[dh][s][1] = *(const s16x4*)(vptr + (size_t)dh * 32 * MT + s * 16 + 8); }
        f32x16 sc = {};
#pragma unroll
        for (int ds = 0; ds < 4; ++ds) sc = MFMA32(kf[ds], qr[ds], sc);
        const int rrow = (rs + (kt >> 1) - r + 7) * 31, kc0 = 32 * (kt & 1);
#pragma unroll
        for (int i = 0; i < 16; ++i) {
            const int kc = kc0 + crow(i, hi);
            const bool valid = kc >= cs && kc < cs + 16;
            const int bi = valid ? rrow + (kc - cq + 15) : 0;
            const float b = tbl[bi];
            sc[i] = valid ? sc[i] * 0.125f + b : NEGBIG;
        }
        softmax_pv(sc, m, l, o0, o1, v);
    }
    l += __shfl_xor(l, 32);
    attn_store(MIX + (size_t)(m0 + r32) * D + 512 + h * 64 + 4 * hi, o0, o1, 1.0f / l);
}

constexpr int NAT_COLS = 64, NAT_ROWS = 16;
__device__ __forceinline__ void na_fill_table(const PP P, int h, LAS float* tbl, int lane) {
    const float* rpb = P.in(18) + h * 465;
#pragma unroll
    for (int k = 0; k < 16; ++k) {
        const int e = lane + 64 * k, row = e >> 6, col = e & 63, off = col - 32;
        float v = 0.f;
        if (row == 15) v = NEGBIG;
        else if (off >= -15 && off <= 15) v = rpb[row * 31 + off + 15] * LOG2E;
        tbl[e] = v;
    }
}
__device__ __forceinline__ void na_task3(const PP P, int idx, LAS float* tbl, int lane) {
    const int cbk = idx & 3, h = (idx >> 2) & 7, RP = idx >> 5;
    const int mp = RP * 128;
    int row0, rows; if (mp < M_P) { row0 = mp & ~4095; rows = 64; } else { row0 = M_P + ((mp - M_P) & ~2047); rows = 32; }
    const int r = (mp - row0) >> 6;
    int rs0 = r - 4; rs0 = rs0 < 0 ? 0 : (rs0 > rows - 8 ? rows - 8 : rs0);
    int rs1 = r - 3; rs1 = rs1 < 0 ? 0 : (rs1 > rows - 8 ? rows - 8 : rs1);
    const int nkr = rs1 + 8 - rs0;
    const int r32 = lane & 31, hi = lane >> 5;
    const int c0 = 16 * cbk; int cw = c0 - 8; cw = cw < 0 ? 0 : (cw > 32 ? 32 : cw);
    const int qrow = r + (r32 >> 4), qcol = c0 + (r32 & 15), rsq = (r32 >> 4) ? rs1 : rs0;
    int cs = qcol - 8; cs = cs < 0 ? 0 : (cs > 48 ? 48 : cs);
    const int qtok = row0 + qrow * 64 + qcol;
    const bf16_t* Z = (const bf16_t*)(P.ws() + WS_Z); const bf16_t* VT = (const bf16_t*)(P.ws() + WS_VT); bf16_t* MIX = (bf16_t*)(P.ws() + WS_MIX);
    const bf16_t* qp = Z + (size_t)qtok * ZLD0 + 512 + h * 64 + hi * 8;
    bf16x8 qr[4];
#pragma unroll
    for (int ds = 0; ds < 4; ++ds) qr[ds] = *(const bf16x8*)(qp + ds * 16);
    const int kperm = (r32 & 0x13) | ((r32 & 8) >> 1) | ((r32 & 4) << 1);
    const int kcb = cw + 8 * hi;
    float cm[16];
#pragma unroll
    for (int i = 0; i < 16; ++i) { const int kc = kcb + (i & 7) + 16 * (i >> 3); cm[i] = (kc >= cs && kc < cs + 16) ? 0.f : NEGBIG; }
    const int colix = kcb - qcol + 32;
    float m = -1.0e4f, l = 0.f;
    f32x16 o0 = {}, o1 = {};
    const bf16_t* kbase = Z + (size_t)(row0 + rs0 * 64 + cw + kperm) * ZLD0 + 1024 + h * 64 + hi * 8;
    const bf16_t* vbase = VT + (size_t)(h * 64 + r32) * MT + row0 + rs0 * 64 + cw + hi * 8;
    bf16x8 kf[4]; bf16x8 v[2][2];
#define NA_LOAD(KF, V, t_) do { const bf16_t* kp_ = kbase + (size_t)(t_) * 64 * ZLD0; const bf16_t* vp_ = vbase + (t_) * 64; \
        _Pragma("unroll") for (int ds = 0; ds < 4; ++ds) KF[ds] = *(const bf16x8*)(kp_ + ds * 16); \
        _Pragma("unroll") for (int dh = 0; dh < 2; ++dh) _Pragma("unroll") for (int s = 0; s < 2; ++s) V[dh][s] = *(const bf16x8*)(vp_ + (size_t)dh * 32 * MT + s * 16); } while (0)
    NA_LOAD(kf, v, 0);
    bf16x8 nk[4]; bf16x8 nv[2][2];
    NA_LOAD(nk, nv, 1);
    for (int t = 0; t < nkr; ++t) {
        bf16x8 fk[4]; bf16x8 fv[2][2];
        const int tn = t + 2 < nkr ? t + 2 : nkr - 1;
        NA_LOAD(fk, fv, tn);
        f32x16 sc = {};
#pragma unroll
        for (int ds = 0; ds < 4; ++ds) sc = MFMA32(kf[ds], qr[ds], sc);
        const int kr = rs0 + t;
        const int trow = (kr >= rsq && kr < rsq + 8) ? kr - qrow + 7 : 15;
        const LAS float* tp = tbl + trow * NAT_COLS + colix;
#pragma unroll
        for (int i = 0; i < 16; ++i) sc[i] = (sc[i] * (0.125f * LOG2E) + tp[(i & 7) + 16 * (i >> 3)]) + cm[i];
        softmax2_pv(sc, m, l, o0, o1, v);
#pragma unroll
        for (int ds = 0; ds < 4; ++ds) { kf[ds] = nk[ds]; nk[ds] = fk[ds]; }
#pragma unroll
        for (int dh = 0; dh < 2; ++dh)
#pragma unroll
            for (int s = 0; s < 2; ++s) { v[dh][s] = nv[dh][s]; nv[dh][s] = fv[dh][s]; }
    }
#undef NA_LOAD
    l += __shfl_xor(l, 32);
    attn_store(MIX + (size_t)qtok * D + 512 + h * 64 + 4 * hi, o0, o1, 1.0f / l);
}

__device__ __forceinline__ void na_task4(const PP P, int idx, LAS float* tbl, int lane) {
    const int cbk = idx & 3, h = (idx >> 2) & 7, RQ = idx >> 5;
    const int mp = RQ * 256;
    int row0, rows; if (mp < M_P) { row0 = mp & ~4095; rows = 64; } else { row0 = M_P + ((mp - M_P) & ~2047); rows = 32; }
    const int r = (mp - row0) >> 6;
    int rsv[4];
#pragma unroll
    for (int k = 0; k < 4; ++k) { int x = r + k - 4; rsv[k] = x < 0 ? 0 : (x > rows - 8 ? rows - 8 : x); }
    const int rs0 = rsv[0], nkr = rsv[3] + 8 - rs0;
    const int r32 = lane & 31, hi = lane >> 5, sub = r32 >> 4;
    const int c0 = 16 * cbk; int cw = c0 - 8; cw = cw < 0 ? 0 : (cw > 32 ? 32 : cw);
    const int qcol = c0 + (r32 & 15);
    const int qrowA = r + sub, qrowB = r + 2 + sub, rsqA = sub ? rsv[1] : rsv[0], rsqB = sub ? rsv[3] : rsv[2];
    int cs = qcol - 8; cs = cs < 0 ? 0 : (cs > 48 ? 48 : cs);
    const int qtokA = row0 + qrowA * 64 + qcol, qtokB = qtokA + 128;
    const bf16_t* Z = (const bf16_t*)(P.ws() + WS_Z); const bf16_t* VT = (const bf16_t*)(P.ws() + WS_VT); bf16_t* MIX = (bf16_t*)(P.ws() + WS_MIX);
    bf16x8 qrA[4], qrB[4];
    { const bf16_t* qp = Z + (size_t)qtokA * ZLD0 + 512 + h * 64 + hi * 8;
#pragma unroll
      for (int ds = 0; ds < 4; ++ds) { qrA[ds] = *(const bf16x8*)(qp + ds * 16); qrB[ds] = *(const bf16x8*)(qp + (size_t)128 * ZLD0 + ds * 16); } }
    const int kperm = (r32 & 0x13) | ((r32 & 8) >> 1) | ((r32 & 4) << 1);
    const int kcb = cw + 8 * hi;
    float cm[16];
#pragma unroll
    for (int i = 0; i < 16; ++i) { const int kc = kcb + (i & 7) + 16 * (i >> 3); cm[i] = (kc >= cs && kc < cs + 16) ? 0.f : NEGBIG; }
    const int colix = kcb - qcol + 32;
    float mA = -1.0e4f, lA = 0.f, mB = -1.0e4f, lB = 0.f;
    f32x16 oA0 = {}, oA1 = {}, oB0 = {}, oB1 = {};
    const bf16_t* kbase = Z + (size_t)(row0 + rs0 * 64 + cw + kperm) * ZLD0 + 1024 + h * 64 + hi * 8;
    const bf16_t* vbase = VT + (size_t)(h * 64 + r32) * MT + row0 + rs0 * 64 + cw + hi * 8;
    bf16x8 kf[4], v[2][2];
#define NA_LOAD(KF, V, t_) do { const bf16_t* kp_ = kbase + (size_t)(t_) * 64 * ZLD0; const bf16_t* vp_ = vbase + (t_) * 64; \
        _Pragma("unroll") for (int ds = 0; ds < 4; ++ds) KF[ds] = *(const bf16x8*)(kp_ + ds * 16); \
        _Pragma("unroll") for (int dh = 0; dh < 2; ++dh) _Pragma("unroll") for (int s = 0; s < 2; ++s) V[dh][s] = *(const bf16x8*)(vp_ + (size_t)dh * 32 * MT + s * 16); } while (0)
    NA_LOAD(kf, v, 0);
    const int endA = rsv[1] + 8, begB = rsv[2];
    for (int t = 0; t < nkr; ++t) {
        bf16x8 nk[4], nv[2][2];
        const int tn = t + 1 < nkr ? t + 1 : t;
        NA_LOAD(nk, nv, tn);
        const int kr = rs0 + t;
        if (kr < endA) {
            f32x16 sc = {};
#pragma unroll
            for (int ds = 0; ds < 4; ++ds) sc = MFMA32(kf[ds], qrA[ds], sc);
            const int trow = (kr >= rsqA && kr < rsqA + 8) ? kr - qrowA + 7 : 15;
            const LAS float* tp = tbl + trow * NAT_COLS + colix;
#pragma unroll
            for (int i = 0; i < 16; ++i) sc[i] = (sc[i] * (0.125f * LOG2E) + tp[(i & 7) + 16 * (i >> 3)]) + cm[i];
            softmax2_pv(sc, mA, lA, oA0, oA1, v);
        }
        if (kr >= begB) {
            f32x16 sc = {};
#pragma unroll
            for (int ds = 0; ds < 4; ++ds) sc = MFMA32(kf[ds], qrB[ds], sc);
            const int trow = (kr >= rsqB && kr < rsqB + 8) ? kr - qrowB + 7 : 15;
            const LAS float* tp = tbl + trow * NAT_COLS + colix;
#pragma unroll
            for (int i = 0; i < 16; ++i) sc[i] = (sc[i] * (0.125f * LOG2E) + tp[(i & 7) + 16 * (i >> 3)]) + cm[i];
            softmax2_pv(sc, mB, lB, oB0, oB1, v);
        }
#pragma unroll
        for (int ds = 0; ds < 4; ++ds) kf[ds] = nk[ds];
#pragma unroll
        for (int dh = 0; dh < 2; ++dh)
#pragma unroll
            for (int s = 0; s < 2; ++s) v[dh][s] = nv[dh][s];
    }
#undef NA_LOAD
    lA += __shfl_xor(lA, 32); lB += __shfl_xor(lB, 32);
    attn_store(MIX + (size_t)qtokA * D + 512 + h * 64 + 4 * hi, oA0, oA1, 1.0f / lA);
    attn_store(MIX + (size_t)qtokB * D + 512 + h * 64 + 4 * hi, oB0, oB1, 1.0f / lB);
}

enum { PH_PRO, PH_FFN1, PH_FFN2, PH_RMS, PH_INPROJ, PH_MIX0, PH_COMB, PH_GLU, PH_OUTPROJ, PH_GQA, PH_NOP };
constexpr int NPH = 18;
#ifndef DIS_MASK
#define DIS_MASK 0
#endif
#define EN(t) (!((DIS_MASK >> (t)) & 1))
__constant__ int c_ptype[NPH] = {PH_PRO, PH_FFN1, PH_FFN2, PH_INPROJ, PH_MIX0, PH_COMB, PH_GLU, PH_OUTPROJ, PH_FFN1, PH_FFN2, PH_FFN1, PH_FFN2, PH_INPROJ, PH_GQA, PH_OUTPROJ, PH_FFN1, PH_FFN2, PH_RMS};
__constant__ int c_parg[NPH] = {0, 0, 0, 0, 0, 0, 0, 0, 1, 1, 2, 2, 1, 0, 1, 3, 3, 6};
__constant__ int c_psq[NPH] = {0, 0, 1, 1, 0, 0, 0, 2, 2, 3, 3, 4, 4, 0, 5, 5, 6, 0};

__global__ void __launch_bounds__(NTHREADS, 2) mk_fwd(Params Pk) {
    extern __shared__ __attribute__((aligned(16))) unsigned char lds_raw[];
    cg::grid_group grid = cg::this_grid();
    LAS unsigned char* lds = (LAS unsigned char*)lds_raw;
    const int tid0 = threadIdx.x;
    if (tid0 < 8) ((volatile LAS unsigned*)(lds + 131072))[tid0] = 0u;
    __syncthreads();
    const XcdBarrier xbar = xcd_barrier_post((unsigned*)(Pk.ws + WS_BAR), (volatile LAS unsigned*)(lds + 131072));
    const int G0 = gridDim.x, cb0 = blockIdx.x;

    for (int ph = 0; ph < NPH; ++ph) {
        PP P; P.ka = (const CAS unsigned char*)__builtin_amdgcn_kernarg_segment_ptr();
        asm volatile("" : "+s"(P.ka));
        unsigned char* ws = P.ws();
        int tid = tid0; asm volatile("" : "+v"(tid));
        int G = G0, cb = cb0; asm volatile("" : "+s"(G), "+s"(cb));
        const int lane = tid & 63, wave = __builtin_amdgcn_readfirstlane(tid >> 6);
        const int gw = cb * 8 + wave, ngw = G * 8;
        LAS unsigned char* wl = lds + wave * 16384;
        const int type = c_ptype[ph], arg = c_parg[ph], sqi = c_psq[ph];
        if (type == PH_PRO && EN(PH_PRO)) {
            prologue_weights(P, (LAS float*)wl, gw, ngw, lane);
            prologue_tables(P, tid);
            if (cb == 0 && tid == 0) *(unsigned*)(ws + WS_CTR) = 0u;
            rms_pass(P, P.in(2), 0, gw, ngw, lane);
        } else if (type == PH_FFN1 && EN(PH_FFN1)) {
            pg8::Gemm g{(const bf16_t*)(ws + WS_XN), (const bf16_t*)(ws + WS_W1) + (size_t)arg * 2 * DFF * D, MT, 2 * DFF, D};
            pg8::StaticOrder S; S.init(MT, 2 * DFF, G, cb);
            if (tid < 8) ((LAS int*)(lds + 131072 + 4096 + 4096))[tid] = -1;
            pg8::EpiSwiGLU E{(bf16_t*)(ws + WS_HZ), DFF, (const float*)((unsigned char*)P.out() + OUT_SSQ) + (size_t)sqi * MT * 16, (LAS float*)(lds + 131072 + 4096)};
            pg8::gemm_phase<pg8::EpiSwiGLU, pg8::StaticOrder, true, true>(lds, g, S, E);
        } else if ((type == PH_FFN2 || type == PH_OUTPROJ) && EN(PH_FFN2)) {
            pg8::Gemm g;
            float scale;
            if (type == PH_FFN2) { g = pg8::Gemm{(const bf16_t*)(ws + WS_HZ), (const bf16_t*)(ws + WS_W2) + (size_t)(arg & 3) * D * DFF, MT, D, DFF}; scale = 0.5f; }
            else { g = pg8::Gemm{(const bf16_t*)(ws + WS_MIX), (const bf16_t*)(ws + ((arg & 3) ? WS_WOO : WS_WOE)), MT, D, D}; scale = 1.0f; }
            if (arg & 8) scale = 0.f;
            pg8::StaticOrder S; S.init(MT, D, G, cb);
            pg8::EpiResAdd E{(bf16_t*)(ws + WS_XN), D, scale, (float*)((unsigned char*)P.out() + OUT_SSQ) + (size_t)sqi * MT * 16};
            pg8::gemm_phase<pg8::EpiResAdd, pg8::StaticOrder, true, true>(lds, g, S, E);
        } else if (type == PH_RMS && EN(PH_RMS)) {
            const float* gain = arg < 4 ? P.in(2) + arg * D : (arg < 6 ? P.in(6) + (arg - 4) * D : P.in(24));
            rms_pass(P, gain, 2, gw, ngw, lane);
        } else if (type == PH_INPROJ && EN(PH_INPROJ)) {
            for (int part = 0; part < 2; ++part) {
                pg8::Gemm g; pg8::EpiStore E; pg8::StaticOrder S;
                if (part == 0) {
                    const int N = arg ? ZLD1 : ZLD0;
                    g = pg8::Gemm{(const bf16_t*)(ws + WS_XN), (const bf16_t*)(ws + (arg ? WS_WINO : WS_WINE)), MT, N, D};
                    E = pg8::EpiStore{(bf16_t*)(ws + WS_Z), (size_t)N, (const float*)((unsigned char*)P.out() + OUT_SSQ) + (size_t)sqi * MT * 16, 0}; S.init(MT, N, G, cb);
                } else {
                    const int NV = arg ? 256 : 512;
                    g = pg8::Gemm{(const bf16_t*)(ws + (arg ? WS_WVO : WS_WVE)), (const bf16_t*)(ws + WS_XN), NV, MT, D};
                    E = pg8::EpiStore{(bf16_t*)(ws + WS_VT), (size_t)MT, (const float*)((unsigned char*)P.out() + OUT_SSQ) + (size_t)sqi * MT * 16, 1}; S.init(NV, MT, G, cb);
                }
                pg8::gemm_phase<pg8::EpiStore, pg8::StaticOrder, true, true>(lds, g, S, E);
            }
        } else if (type == PH_MIX0 && EN(PH_MIX0)) {
            {
                const int i = wave * G + cb, nw = 8 * G;
                for (int t = i; t < 1280; t += nw) {
                    int pair, dir, g, s0;
                    if (t < 256) { pair = t >> 6; dir = (t >> 5) & 1; g = t & 31; s0 = 2 * pair; } else { const int u = t - 256; pair = u >> 6; dir = (u >> 5) & 1; g = u & 31; s0 = 8 + 2 * pair; }
                    __builtin_amdgcn_s_setprio(3);
                    if (dir) s5_task2<1>(P, s0, s0 + 1, g, wl, lane); else s5_task2<0>(P, s0, s0 + 1, g, wl, lane);
                    __builtin_amdgcn_s_setprio(0);
                }
                unsigned* ctr = (unsigned*)(ws + WS_CTR);
                for (;;) {
                    unsigned t0 = 0;
                    if (lane == 0) t0 = __hip_atomic_fetch_add(ctr, 2u, __ATOMIC_RELAXED, __HIP_MEMORY_SCOPE_AGENT);
                    t0 = (unsigned)__builtin_amdgcn_readfirstlane((int)t0);
                    if (t0 >= 12288u) break;
                    na_fill_table(P, ((int)t0 >> 2) & 7, (LAS float*)(wl + 9216), lane);
                    for (int k = 0; k < 2; ++k) na_task4(P, (int)t0 + k, (LAS float*)(wl + 9216), lane);
                }
            }
        } else if (type == PH_COMB && EN(PH_COMB)) {
            s5_combine(P, cb * NTHREADS + tid, G * NTHREADS);
        } else if (type == PH_GLU && EN(PH_GLU)) {
            const bf16_t* Gp = (const bf16_t*)((unsigned char*)P.out() + OUT_G);
            pg8::Gemm g{Gp, (const bf16_t*)(ws + WS_WGLU), MT, 512, 512};
            pg8::StaticOrder S; S.init(MT, 512, G, cb);
            pg8::EpiGLU E{Gp, 512, P.in(17), (bf16_t*)(ws + WS_MIX), D};
            pg8::gemm_phase<pg8::EpiGLU, pg8::StaticOrder, true, true>(lds, g, S, E);
        } else if (type == PH_NOP) {
            if (arg == 1 && cb == 0 && tid == 0) *(unsigned*)(ws + WS_CTR) = 0u;
        } else if (type == PH_GQA && EN(PH_GQA)) {
            gqa_phase(P, lds, tid, cb, G);
        }
        if (ph + 1 < NPH) { if (ph == 0) grid.sync(); else xcd_barrier(xbar); }
    }
}

extern "C" void kernel_launch(void* const* d_in, const int* in_sizes, int n_in, void* d_out, int out_size, void* d_ws, size_t ws_size, hipStream_t stream) {
    static int grid = 0;
    if (grid == 0) {
        if (n_in != 25 || out_size != MT * D || ws_size < WS_END) { fprintf(stderr, "kernel_launch: unexpected shapes: n_in %d out %d ws %zu (need %zu)\n", n_in, out_size, ws_size, (size_t)WS_END); grid = -1; return; }
        int dev = 0, cus = 0, per_cu = 0;
        (void)hipGetDevice(&dev);
        (void)hipDeviceGetAttribute(&cus, hipDeviceAttributeMultiprocessorCount, dev);
        if (hipFuncSetAttribute((const void*)mk_fwd, hipFuncAttributeMaxDynamicSharedMemorySize, LDS_BYTES) != hipSuccess) { fprintf(stderr, "kernel_launch: hipFuncSetAttribute failed\n"); grid = -1; return; }
        if (hipOccupancyMaxActiveBlocksPerMultiprocessor(&per_cu, (const void*)mk_fwd, NTHREADS, LDS_BYTES) != hipSuccess || per_cu < 1) { fprintf(stderr, "kernel_launch: occupancy query says %d blocks per CU\n", per_cu); (void)hipGetLastError(); per_cu = 1; }
        grid = cus;
    }
    if (grid < 0) return;
    if (hipMemsetAsync(d_ws, 0, 65536, stream) != hipSuccess) { fprintf(stderr, "kernel_launch: memset failed\n"); return; }
    Params p{};
    for (int i = 0; i < 25; ++i) p.in[i] = (const float*)d_in[i];
    p.out = (float*)d_out; p.ws = (unsigned char*)d_ws;
    void* args[] = {&p};
    hipError_t e = hipLaunchCooperativeKernel((const void*)mk_fwd, dim3(grid), dim3(NTHREADS), args, LDS_BYTES, stream);
    if (e != hipSuccess) fprintf(stderr, "kernel_launch: cooperative launch failed: %s (grid %d)\n", hipGetErrorString(e), grid);
}
```

```cpp
#include <hip/hip_runtime.h>
#include <hip/hip_cooperative_groups.h>
#include <cstdio>
#include <cstdint>
#include <cmath>
namespace cg = cooperative_groups;
namespace pg8 {
#define PG8_LAS __attribute__((address_space(3)))
typedef unsigned short bf16_t;
typedef short bf16x8 __attribute__((ext_vector_type(8)));
typedef float f32x4 __attribute__((ext_vector_type(4)));
typedef unsigned u32x4 __attribute__((ext_vector_type(4)));
constexpr int BM = 256, BK = 64, HALF = 128, HTB = HALF * BK * 2  , STAGE_BYTES = 8 * HTB, NXCD = 8, WGM = 8;

__host__ __device__ __forceinline__ int lds_byte(int r, int c) { const int st = (r >> 4) * 2 + (c >> 5), rr = r & 15, cc = c & 31, ob = rr * 64 + cc * 2; return st * 1024 + (ob ^ (((ob >> 9) & 1) << 5)); }
__host__ __device__ __forceinline__ void stage_rc(int b, int& R, int& C) { const int st = b / 1024, sb = b % 1024, swz = sb ^ (((sb >> 9) & 1) << 5); R = (st >> 1) * 16 + swz / 64; C = (st & 1) * 32 + (swz % 64) / 2; }
__host__ __device__ __forceinline__ int perm32(int rho) { const int n = rho >> 4, i = rho & 15; return 8 * (i >> 2) + 4 * n + (i & 3); }

struct Unit { int pm, pn; };
struct Gemm { const bf16_t* A; const bf16_t* Bt; int M, N, K; };

struct StaticOrder {
    int nM, nN, nwg, G, c;
    __host__ __device__ void init(int M, int N, int G_, int c_) { nM = M / BM; nN = N / BM; nwg = nM * nN; G = G_; c = c_; }
    __host__ __device__ bool next(int i, Unit& u) const {
        const long L = (long)i * G + c; if (L >= nwg) return false;
        int wgid = (int)L; { const int q = nwg / NXCD, r = nwg % NXCD, xcd = wgid % NXCD, off = wgid / NXCD; wgid = (xcd < r ? xcd * (q + 1) : r * (q + 1) + (xcd - r) * q) + off; }
        const int nig = WGM * nN, gid = wgid / nig, fm = gid * WGM, gsz = (nM - fm) < WGM ? (nM - fm) : WGM;
        u.pm = fm + ((wgid % nig) % gsz); u.pn = (wgid % nig) / gsz; return true;
    }
    __device__ __forceinline__ void a_ready(const Unit&) const {}
    __device__ __forceinline__ void done(const Unit&) const {}
};
__device__ __forceinline__ unsigned cvt_pk_bf16(float lo, float hi) { unsigned r; asm volatile("v_cvt_pk_bf16_f32 %0, %1, %2" : "=v"(r) : "v"(lo), "v"(hi)); return r; }
typedef float f32x2 __attribute__((ext_vector_type(2)));
typedef unsigned u32x2 __attribute__((ext_vector_type(2)));
__device__ __forceinline__ float fast_sigmoid(float v) { return __builtin_amdgcn_rcpf(1.0f + __expf(-v)); }
__device__ __forceinline__ float rstd16(const float* p) {
    const f32x4 a = *(const f32x4*)p, b = *(const f32x4*)(p + 4), c = *(const f32x4*)(p + 8), d = *(const f32x4*)(p + 12);
    const float s = (((a[0] + a[1]) + (a[2] + a[3])) + ((b[0] + b[1]) + (b[2] + b[3]))) + (((c[0] + c[1]) + (c[2] + c[3])) + ((d[0] + d[1]) + (d[2] + d[3])));
    return __builtin_amdgcn_rsqf(s * (1.0f / 1024.0f) + 1e-6f);
}
__device__ __forceinline__ float rstd16q(const float* p, int fq) {
    const f32x4 a = *(const f32x4*)(p + 4 * fq);
    float s = (a[0] + a[1]) + (a[2] + a[3]);
    s += __shfl_xor(s, 16); s += __shfl_xor(s, 32);
    return __builtin_amdgcn_rsqf(s * (1.0f / 1024.0f) + 1e-6f);
}
struct EpiSwiGLU {
    static constexpr bool PERM = true, AFTER_DRAIN = false;
    __device__ __forceinline__ void prefetch(const Unit&, int, int, int, int, PG8_LAS unsigned char*, int) const {}
    bf16_t* H; int ldh; const float* ssq;
    PG8_LAS float* rcache;
    __device__ __forceinline__ void operator()(const f32x4 (&acc)[2][2][4][2], const Unit& u, int wr, int wc, int fr, int fq) const {
        const int row0 = u.pm * BM + wr * 64 + fr, col0 = u.pn * HALF + wc * 32 + 8 * fq;
        float rsv[2][4];
        const int wid_ = wr * 4 + wc;
        PG8_LAS float* rc = rcache + wid_ * 128 + fr;
        PG8_LAS int* tag = (PG8_LAS int*)(rcache + 1024) + wid_;
        if (*tag != u.pm) {
            f32x4 pq[2][4];
#pragma unroll
            for (int ai = 0; ai < 2; ++ai)
#pragma unroll
                for (int m = 0; m < 4; ++m) pq[ai][m] = *(const f32x4*)(ssq + (size_t)(row0 + ai * HALF + m * 16) * 16 + 4 * fq);
#pragma unroll
            for (int ai = 0; ai < 2; ++ai)
#pragma unroll
                for (int m = 0; m < 4; ++m) { float s = (pq[ai][m][0] + pq[ai][m][1]) + (pq[ai][m][2] + pq[ai][m][3]); s += __shfl_xor(s, 16); s += __shfl_xor(s, 32); rsv[ai][m] = __builtin_amdgcn_rsqf(s * (1.0f / 1024.0f) + 1e-6f);
                    if (fq == 0) rc[(ai * 4 + m) * 16] = rsv[ai][m]; }
            if (fr == 0 && fq == 0) *tag = u.pm;
        } else {
#pragma unroll
            for (int ai = 0; ai < 2; ++ai)
#pragma unroll
                for (int m = 0; m < 4; ++m) rsv[ai][m] = rc[(ai * 4 + m) * 16];
        }
#pragma unroll
        for (int ai = 0; ai < 2; ++ai)
#pragma unroll
            for (int m = 0; m < 4; ++m) {
                bf16_t* rowp = H + (size_t)(row0 + ai * HALF + m * 16) * ldh + col0;
                const float rs = rsv[ai][m], rsl = rs * -1.4426950408889634f, rs2 = rs * rs;
                float tq[8], pq8[8], hv[8];
#pragma unroll
                for (int k = 0; k < 8; ++k) { tq[k] = acc[ai][0][m][k >> 2][k & 3] * rsl; asm volatile("" : "+v"(tq[k])); }
#pragma unroll
                for (int k = 0; k < 8; ++k) { tq[k] = __builtin_amdgcn_exp2f(tq[k]); asm volatile("" : "+v"(tq[k])); }
#pragma unroll
                for (int k = 0; k < 8; ++k) { pq8[k] = acc[ai][0][m][k >> 2][k & 3] * acc[ai][1][m][k >> 2][k & 3]; asm volatile("" : "+v"(pq8[k])); }
#pragma unroll
                for (int k = 0; k < 8; ++k) { tq[k] = tq[k] + 1.0f; asm volatile("" : "+v"(tq[k])); }
#pragma unroll
                for (int k = 0; k < 8; ++k) { tq[k] = __builtin_amdgcn_rcpf(tq[k]); asm volatile("" : "+v"(tq[k])); }
#pragma unroll
                for (int k = 0; k < 8; ++k) { pq8[k] = pq8[k] * rs2; asm volatile("" : "+v"(pq8[k])); }
#pragma unroll
                for (int k = 0; k < 8; ++k) hv[k] = pq8[k] * tq[k];
                u32x4 w; w.x = cvt_pk_bf16(hv[0], hv[1]); w.y = cvt_pk_bf16(hv[2], hv[3]); w.z = cvt_pk_bf16(hv[4], hv[5]); w.w = cvt_pk_bf16(hv[6], hv[7]);
                __builtin_nontemporal_store(w, (u32x4*)rowp);
            }
    }
};
struct EpiResAdd {
    static constexpr bool PERM = true, AFTER_DRAIN = false;
    bf16_t* XB; int ldx; float scale; float* ssq;
    __device__ __forceinline__ void prefetch(const Unit& u, int wr, int wc, int fr, int fq, PG8_LAS unsigned char* lds, int wid) const {
        PG8_LAS unsigned* dummy = (PG8_LAS unsigned*)(lds + 131072 + 1024 + wid * 256);
        const unsigned lane_off = (unsigned)(fr * ldx + 8 * fq) * 2u;
        const char* ub = (const char*)XB + ((size_t)(u.pm * BM + wr * 64) * ldx + u.pn * BM + wc * 32) * 2;
#pragma unroll
        for (int ai = 0; ai < 2; ++ai)
#pragma unroll
            for (int m = 0; m < 4; ++m)
#pragma unroll
                for (int bj = 0; bj < 2; ++bj) {
                    const char* up = ub + ((size_t)(ai * HALF + m * 16) * ldx + bj * HALF) * 2;
                    __builtin_amdgcn_global_load_lds((const unsigned*)(up + lane_off), dummy, 4, 0, 0);
                }
    }
    __device__ __forceinline__ void operator()(const f32x4 (&acc)[2][2][4][2], const Unit& u, int wr, int wc, int fr, int fq) const {
        const int row0 = u.pm * BM + wr * 64 + fr, col0 = u.pn * BM + wc * 32 + 8 * fq;
        const unsigned lane_off = (unsigned)(fr * ldx + 8 * fq) * 2u;
        const char* ub = (const char*)XB + ((size_t)(u.pm * BM + wr * 64) * ldx + u.pn * BM + wc * 32) * 2;
        u32x4 ow[2][4][2];
#pragma unroll
        for (int ai = 0; ai < 2; ++ai)
#pragma unroll
            for (int m = 0; m < 4; ++m)
#pragma unroll
                for (int bj = 0; bj < 2; ++bj) ow[ai][m][bj] = *(const u32x4*)(ub + ((size_t)(ai * HALF + m * 16) * ldx + bj * HALF) * 2 + lane_off);
#pragma unroll
        for (int ai = 0; ai < 2; ++ai)
#pragma unroll
            for (int m = 0; m < 4; ++m) {
                char* bp = (char*)ub + (size_t)(ai * HALF + m * 16) * ldx * 2;
                float sq = 0.f;
#pragma unroll
                for (int bj = 0; bj < 2; ++bj) {
                    const u32x4 w0 = ow[ai][m][bj];
                    const f32x4 a0 = acc[ai][bj][m][0] * scale, a1 = acc[ai][bj][m][1] * scale;
                    float o[8];
                    o[0] = __uint_as_float(w0.x << 16) + a0[0]; o[1] = __uint_as_float(w0.x & 0xffff0000u) + a0[1]; o[2] = __uint_as_float(w0.y << 16) + a0[2]; o[3] = __uint_as_float(w0.y & 0xffff0000u) + a0[3];
                    o[4] = __uint_as_float(w0.z << 16) + a1[0]; o[5] = __uint_as_float(w0.z & 0xffff0000u) + a1[1]; o[6] = __uint_as_float(w0.w << 16) + a1[2]; o[7] = __uint_as_float(w0.w & 0xffff0000u) + a1[3];
                    sq += ((o[0] * o[0] + o[1] * o[1]) + (o[2] * o[2] + o[3] * o[3])) + ((o[4] * o[4] + o[5] * o[5]) + (o[6] * o[6] + o[7] * o[7]));
                    u32x4 w; w.x = cvt_pk_bf16(o[0], o[1]); w.y = cvt_pk_bf16(o[2], o[3]); w.z = cvt_pk_bf16(o[4], o[5]); w.w = cvt_pk_bf16(o[6], o[7]);
                    *(u32x4*)(bp + bj * HALF * 2 + lane_off) = w;
                }
                sq += __shfl_xor(sq, 16); sq += __shfl_xor(sq, 32);
                if (fq == 0) ssq[(size_t)(row0 + ai * HALF + m * 16) * 16 + u.pn * 4 + wc] = sq;
            }
    }
};
struct EpiStore {
    static constexpr bool PERM = true, AFTER_DRAIN = false;
    __device__ __forceinline__ void prefetch(const Unit&, int, int, int, int, PG8_LAS unsigned char*, int) const {}
    bf16_t* O; size_t ldc; const float* ssq; int colmode;
    __device__ __forceinline__ void operator()(const f32x4 (&acc)[2][2][4][2], const Unit& u, int wr, int wc, int fr, int fq) const {
        const int row0 = u.pm * BM + wr * 64 + fr, col0 = u.pn * BM + wc * 32 + 8 * fq;
        float rsv[2][4], crs[2][8];
#pragma unroll
        for (int bj = 0; bj < 2; ++bj)
#pragma unroll
            for (int k = 0; k < 8; ++k) crs[bj][k] = 1.0f;
        if (!colmode) {
            f32x4 pq[2][4];
#pragma unroll
            for (int ai = 0; ai < 2; ++ai)
#pragma unroll
                for (int m = 0; m < 4; ++m) pq[ai][m] = *(const f32x4*)(ssq + (size_t)(row0 + ai * HALF + m * 16) * 16 + 4 * fq);
#pragma unroll
            for (int ai = 0; ai < 2; ++ai)
#pragma unroll
                for (int m = 0; m < 4; ++m) { float s = (pq[ai][m][0] + pq[ai][m][1]) + (pq[ai][m][2] + pq[ai][m][3]); s += __shfl_xor(s, 16); s += __shfl_xor(s, 32); rsv[ai][m] = __builtin_amdgcn_rsqf(s * (1.0f / 1024.0f) + 1e-6f); }
        } else {
#pragma unroll
            for (int ai = 0; ai < 2; ++ai)
#pragma unroll
                for (int m = 0; m < 4; ++m) rsv[ai][m] = 1.0f;
#pragma unroll
            for (int bj = 0; bj < 2; ++bj)
#pragma unroll
                for (int hf = 0; hf < 2; ++hf) {
                    f32x4 q[4][4];
#pragma unroll
                    for (int j = 0; j < 4; ++j)
#pragma unroll
                        for (int t = 0; t < 4; ++t) q[j][t] = *(const f32x4*)(ssq + (size_t)(col0 + bj * HALF + hf * 4 + j) * 16 + 4 * t);
#pragma unroll
                    for (int j = 0; j < 4; ++j) {
                        const f32x4 a = q[j][0], b = q[j][1], c = q[j][2], d = q[j][3];
                        const float s = (((a[0] + a[1]) + (a[2] + a[3])) + ((b[0] + b[1]) + (b[2] + b[3]))) + (((c[0] + c[1]) + (c[2] + c[3])) + ((d[0] + d[1]) + (d[2] + d[3])));
                        crs[bj][hf * 4 + j] = __builtin_amdgcn_rsqf(s * (1.0f / 1024.0f) + 1e-6f);
                    }
                }
        }
#pragma unroll
        for (int ai = 0; ai < 2; ++ai)
#pragma unroll
            for (int m = 0; m < 4; ++m) {
                bf16_t* rowp = O + (size_t)(row0 + ai * HALF + m * 16) * ldc + col0;
                const float rr = rsv[ai][m];
#pragma unroll
                for (int bj = 0; bj < 2; ++bj) { f32x4 v0 = acc[ai][bj][m][0] * rr, v1 = acc[ai][bj][m][1] * rr;
                    if (colmode) {
#pragma unroll
                        for (int j = 0; j < 4; ++j) { v0[j] *= crs[bj][j]; v1[j] *= crs[bj][4 + j]; } }
                    u32x4 w; w.x = cvt_pk_bf16(v0[0], v0[1]); w.y = cvt_pk_bf16(v0[2], v0[3]); w.z = cvt_pk_bf16(v1[0], v1[1]); w.w = cvt_pk_bf16(v1[2], v1[3]);
                    *(u32x4*)(rowp + bj * HALF) = w; }
            }
    }
};
struct EpiGLU {
    static constexpr bool PERM = true, AFTER_DRAIN = false;
    __device__ __forceinline__ void prefetch(const Unit&, int, int, int, int, PG8_LAS unsigned char*, int) const {}
    const bf16_t* G; int ldg; const float* bias; bf16_t* O; int ldo;
    __device__ __forceinline__ void operator()(const f32x4 (&acc)[2][2][4][2], const Unit& u, int wr, int wc, int fr, int fq) const {
        const int row0 = u.pm * BM + wr * 64 + fr, col0 = u.pn * BM + wc * 32 + 8 * fq;
        u32x4 gw_[2][2][4];
#pragma unroll
        for (int bj = 0; bj < 2; ++bj)
#pragma unroll
            for (int ai = 0; ai < 2; ++ai)
#pragma unroll
                for (int m = 0; m < 4; ++m) gw_[bj][ai][m] = *(const u32x4*)(G + (size_t)(row0 + ai * HALF + m * 16) * ldg + col0 + bj * HALF);
#pragma unroll
        for (int bj = 0; bj < 2; ++bj) {
            const f32x4 b0 = *(const f32x4*)(bias + col0 + bj * HALF), b1 = *(const f32x4*)(bias + col0 + bj * HALF + 4);
#pragma unroll
            for (int ai = 0; ai < 2; ++ai)
#pragma unroll
                for (int m = 0; m < 4; ++m) {
                    const size_t r = (size_t)(row0 + ai * HALF + m * 16);
                    const u32x4 gw = gw_[bj][ai][m];
                    const f32x4 v0 = acc[ai][bj][m][0] + b0, v1 = acc[ai][bj][m][1] + b1;
                    float gv[8];
                    gv[0] = __uint_as_float(gw.x << 16); gv[1] = __uint_as_float(gw.x & 0xffff0000u); gv[2] = __uint_as_float(gw.y << 16); gv[3] = __uint_as_float(gw.y & 0xffff0000u);
                    gv[4] = __uint_as_float(gw.z << 16); gv[5] = __uint_as_float(gw.z & 0xffff0000u); gv[6] = __uint_as_float(gw.w << 16); gv[7] = __uint_as_float(gw.w & 0xffff0000u);
                    float ov[8];
#pragma unroll
                    for (int j = 0; j < 4; ++j) { ov[j] = gv[j] * fast_sigmoid(v0[j]); ov[4 + j] = gv[4 + j] * fast_sigmoid(v1[j]); }
                    u32x4 w; w.x = cvt_pk_bf16(ov[0], ov[1]); w.y = cvt_pk_bf16(ov[2], ov[3]); w.z = cvt_pk_bf16(ov[4], ov[5]); w.w = cvt_pk_bf16(ov[6], ov[7]);
                    *(u32x4*)(O + r * ldo + col0 + bj * HALF) = w;
                }
        }
    }
};
template <class Epi, class Sched, bool ALIGN_EPI = false, bool SP2 = false>
__device__ __forceinline__ void gemm_phase(PG8_LAS unsigned char* lds, const Gemm g, const Sched& S, const Epi& E) {
    int tid_ = threadIdx.x; asm volatile("" : "+v"(tid_));
    const int tid = tid_, wid = __builtin_amdgcn_readfirstlane(tid >> 6), lane = tid & 63, wr = wid >> 2, wc = wid & 3, fr = lane & 15, fq = lane >> 4;
    const int K = g.K, nt = K / BK;
    unsigned voffA[2], voffB[2];
#pragma unroll
    for (int i = 0; i < 2; ++i) { int R, C; stage_rc(tid * 16 + i * 8192, R, C); const int Rb = Epi::PERM ? ((R & ~31) + perm32(R & 31)) : R;
        voffA[i] = (unsigned)(R * K + C) * 2u; voffB[i] = (unsigned)(Rb * K + C) * 2u; }
    const size_t kstep = (size_t)(BK * 2);
    const size_t hstep = (size_t)HALF * K * 2;
    const size_t tstep = 2 * hstep;
    const unsigned ldsw = (unsigned)wid * 1024u;
    const int aoff = lds_byte(wr * 64 + fr, fq * 8), boff = lds_byte(wc * 32 + fr, fq * 8);
#define PG8_SA(b, h) (((b) * 2 + (h)) * HTB)
#define PG8_SB(b, h) ((4 + (b) * 2 + (h)) * HTB)
#define PG8_STAGE(bufoff, gbase, voff) do { _Pragma("unroll") for (int _i = 0; _i < 2; ++_i) \
        __builtin_amdgcn_global_load_lds((const unsigned*)((const char*)(gbase) + (voff)[_i]), (PG8_LAS unsigned*)(lds + (bufoff) + ldsw + _i * 8192), 16, 0, 0); } while (0)
#define PG8_LDA(dst, b, h) do { _Pragma("unroll") for (int m = 0; m < 4; ++m) _Pragma("unroll") for (int k = 0; k < 2; ++k) dst[m][k] = *(const PG8_LAS bf16x8*)(lds + PG8_SA(b, h) + aoff + m * 2048 + k * 1024); } while (0)
#define PG8_LDB(dst, b, h) do { _Pragma("unroll") for (int n = 0; n < 2; ++n) _Pragma("unroll") for (int k = 0; k < 2; ++k) dst[n][k] = *(const PG8_LAS bf16x8*)(lds + PG8_SB(b, h) + boff + n * 2048 + k * 1024); } while (0)
#define PG8_MMA(ai, bj, At, Bt) do { __builtin_amdgcn_s_setprio(1); _Pragma("unroll") for (int m = 0; m < 4; ++m) _Pragma("unroll") for (int n = 0; n < 2; ++n) _Pragma("unroll") for (int k = 0; k < 2; ++k) \
        acc[ai][bj][m][n] = __builtin_amdgcn_mfma_f32_16x16x32_bf16(Bt[n][k], At[m][k], acc[ai][bj][m][n], 0, 0, 0); __builtin_amdgcn_s_setprio(0); } while (0)
#define PG8_WAIT_V(n) asm volatile("s_waitcnt vmcnt(" #n ")" ::: "memory")
#define PG8_WAIT_L(n) asm volatile("s_waitcnt lgkmcnt(" #n ")" ::: "memory")
#define PG8_BAR __builtin_amdgcn_s_barrier()
#define PG8_SCHED __builtin_amdgcn_sched_barrier(0)
    Unit cur, nxt; int ui = 0;
    if (!S.next(0, cur)) return;
    f32x4 acc[2][2][4][2];
#pragma unroll
    for (int a = 0; a < 2; ++a)
#pragma unroll
        for (int b = 0; b < 2; ++b)
#pragma unroll
            for (int m = 0; m < 4; ++m)
#pragma unroll
                for (int n = 0; n < 2; ++n) acc[a][b][m][n] = (f32x4){0.f, 0.f, 0.f, 0.f};
    bf16x8 At[4][2], B0[2][2], B1[2][2];
    const char* cA = (const char*)g.A + (size_t)cur.pm * tstep; const char* cB = (const char*)g.Bt + (size_t)cur.pn * tstep;
    S.a_ready(cur);
    if constexpr (SP2) {
        PG8_STAGE(PG8_SB(0, 0), cB, voffB); PG8_STAGE(PG8_SB(0, 1), cB + hstep, voffB); PG8_STAGE(PG8_SA(0, 0), cA, voffA); PG8_STAGE(PG8_SA(0, 1), cA + hstep, voffA);
        if (wr == 1) PG8_BAR;
        PG8_WAIT_V(2); PG8_BAR;
        PG8_STAGE(PG8_SB(1, 0), cB + kstep, voffB); PG8_STAGE(PG8_SA(1, 0), cA + kstep, voffA); PG8_STAGE(PG8_SB(1, 1), cB + hstep + kstep, voffB);
        PG8_WAIT_V(6); PG8_BAR;
    } else {
        PG8_STAGE(PG8_SB(0, 0), cB, voffB); PG8_STAGE(PG8_SA(0, 0), cA, voffA); PG8_STAGE(PG8_SB(0, 1), cB + hstep, voffB); PG8_STAGE(PG8_SA(0, 1), cA + hstep, voffA);
        if (wr == 1) PG8_BAR;
        PG8_WAIT_V(4); PG8_BAR;
        PG8_STAGE(PG8_SB(1, 0), cB + kstep, voffB); PG8_STAGE(PG8_SA(1, 0), cA + kstep, voffA); PG8_STAGE(PG8_SB(1, 1), cB + hstep + kstep, voffB);
        PG8_WAIT_V(6); PG8_BAR;
    }
    for (;;) {
        const bool has_next = S.next(ui + 1, nxt);
        const char* nA = has_next ? (const char*)g.A + (size_t)nxt.pm * tstep : cA; const char* nB = has_next ? (const char*)g.Bt + (size_t)nxt.pn * tstep : cB;
        for (int t = 0; t < nt; t += 2) {
            const bool last = (t == nt - 2);
            const char* a1 = cA + (size_t)(t + 1) * kstep;
            const char* a2 = last ? nA : cA + (size_t)(t + 2) * kstep; const char* b2 = last ? nB : cB + (size_t)(t + 2) * kstep;
            const char* a3 = a2 + kstep; const char* b3 = b2 + kstep;
            if (last && has_next) S.a_ready(nxt);
            if constexpr (SP2) {
            PG8_LDB(B0, 0, 0); PG8_LDB(B1, 0, 1); PG8_SCHED; PG8_LDA(At, 0, 0); PG8_STAGE(PG8_SA(1, 1), a1 + hstep, voffA);
            PG8_WAIT_V(8); PG8_WAIT_L(0); PG8_BAR; PG8_MMA(0, 0, At, B0); PG8_MMA(0, 1, At, B1); PG8_BAR; PG8_SCHED;
            PG8_LDA(At, 0, 1); PG8_STAGE(PG8_SB(0, 0), b2, voffB); PG8_STAGE(PG8_SB(0, 1), b2 + hstep, voffB); PG8_STAGE(PG8_SA(0, 0), a2, voffA);
            PG8_WAIT_V(8); PG8_WAIT_L(0); PG8_BAR; PG8_MMA(1, 0, At, B0); PG8_MMA(1, 1, At, B1); PG8_BAR; PG8_SCHED;
            PG8_LDB(B0, 1, 0); PG8_LDB(B1, 1, 1); PG8_SCHED; PG8_LDA(At, 1, 0); PG8_STAGE(PG8_SA(0, 1), a2 + hstep, voffA);
            PG8_WAIT_V(8); PG8_WAIT_L(0); PG8_BAR; PG8_MMA(0, 0, At, B0); PG8_MMA(0, 1, At, B1); PG8_BAR; PG8_SCHED;
            PG8_LDA(At, 1, 1); PG8_STAGE(PG8_SB(1, 0), b3, voffB); PG8_STAGE(PG8_SB(1, 1), b3 + hstep, voffB); PG8_STAGE(PG8_SA(1, 0), a3, voffA);
            PG8_WAIT_V(8); PG8_WAIT_L(0); PG8_BAR; PG8_MMA(1, 0, At, B0); PG8_MMA(1, 1, At, B1); PG8_BAR; PG8_SCHED;
            } else {
            PG8_LDB(B0, 0, 0); PG8_SCHED; PG8_LDA(At, 0, 0); PG8_STAGE(PG8_SA(1, 1), a1 + hstep, voffA);
            PG8_WAIT_L(8); PG8_BAR; PG8_WAIT_L(0); PG8_MMA(0, 0, At, B0); PG8_BAR; PG8_SCHED;
            PG8_LDB(B1, 0, 1); PG8_STAGE(PG8_SB(0, 0), b2, voffB);
            PG8_BAR; PG8_WAIT_L(0); PG8_MMA(0, 1, At, B1); PG8_BAR;
            PG8_LDA(At, 0, 1); PG8_STAGE(PG8_SA(0, 0), a2, voffA);
            PG8_BAR; PG8_WAIT_L(0); PG8_MMA(1, 0, At, B0); PG8_BAR; PG8_SCHED;
            PG8_STAGE(PG8_SB(0, 1), b2 + hstep, voffB);
            PG8_WAIT_V(6); PG8_BAR; PG8_MMA(1, 1, At, B1); PG8_BAR;
            PG8_LDB(B0, 1, 0); PG8_SCHED; PG8_LDA(At, 1, 0); PG8_STAGE(PG8_SA(0, 1), a2 + hstep, voffA);
            PG8_WAIT_L(8); PG8_BAR; PG8_WAIT_L(0); PG8_MMA(0, 0, At, B0); PG8_BAR; PG8_SCHED;
            PG8_LDB(B1, 1, 1); PG8_STAGE(PG8_SB(1, 0), b3, voffB);
            PG8_BAR; PG8_WAIT_L(0); PG8_MMA(0, 1, At, B1); PG8_BAR;
            PG8_LDA(At, 1, 1); PG8_STAGE(PG8_SA(1, 0), a3, voffA);
            PG8_BAR; PG8_WAIT_L(0); PG8_MMA(1, 0, At, B0); PG8_BAR; PG8_SCHED;
            PG8_STAGE(PG8_SB(1, 1), b3 + hstep, voffB);
            PG8_WAIT_V(6); PG8_BAR; PG8_MMA(1, 1, At, B1); PG8_BAR;
            }
        }
        if constexpr (ALIGN_EPI) { if (wr == 0) PG8_BAR; }
        if constexpr (!Epi::AFTER_DRAIN) { E(acc, cur, wr, wc, fr, fq); S.done(cur); }
        if (!has_next) break;
#pragma unroll
        for (int a = 0; a < 2; ++a)
#pragma unroll
            for (int b = 0; b < 2; ++b)
#pragma unroll
                for (int m = 0; m < 4; ++m)
#pragma unroll
                    for (int n = 0; n < 2; ++n) acc[a][b][m][n] = (f32x4){0.f, 0.f, 0.f, 0.f};
        cur = nxt; cA = nA; cB = nB; ++ui;
        if constexpr (ALIGN_EPI) { if (wr == 1) PG8_BAR; }
    }
    PG8_WAIT_V(0);
    if constexpr (!ALIGN_EPI) { if (wr == 0) PG8_BAR; }
    PG8_BAR;
    if constexpr (Epi::AFTER_DRAIN) { E.fused(acc, cur, wr, wc, fr, fq, lds, wid, lane); S.done(cur); }
#undef PG8_SA
#undef PG8_SB
#undef PG8_STAGE
#undef PG8_LDA
#undef PG8_LDB
#undef PG8_MMA
#undef PG8_WAIT_V
#undef PG8_WAIT_L
#undef PG8_BAR
#undef PG8_SCHED
}
}
#define LAS __attribute__((address_space(3)))
typedef unsigned short bf16_t;
typedef float f32x4 __attribute__((ext_vector_type(4)));
typedef float f32x16 __attribute__((ext_vector_type(16)));
typedef short bf16x8 __attribute__((ext_vector_type(8)));
typedef short s16x4 __attribute__((ext_vector_type(4)));
typedef unsigned u32x4 __attribute__((ext_vector_type(4)));
typedef unsigned u32x2 __attribute__((ext_vector_type(2)));

#define XB_TMO      128
#define XB_XCNT(j)  (256  + 64 * (j))
#define XB_XSUB(j)  (1280 + 64 * (j))
#define XB_XGEN(j)  (2304 + 64 * (j))
#define XB_TOP      3328
#define XB_TOPGEN   3392
#define XCD_BAR_WORDS 3456
#define XB_SPIN_CAP (1u << 18)

__device__ __forceinline__ unsigned xb_ld(unsigned* p)              { return __hip_atomic_load(p, __ATOMIC_RELAXED, __HIP_MEMORY_SCOPE_AGENT); }
__device__ __forceinline__ unsigned xb_add(unsigned* p, unsigned v) { return __hip_atomic_fetch_add(p, v, __ATOMIC_RELAXED, __HIP_MEMORY_SCOPE_AGENT); }
__device__ __forceinline__ unsigned xb_xcc_id() { return (unsigned)__builtin_amdgcn_s_getreg((3 << 11) | 20) & 0xFu; }
#define XB_SPIN(cond, bar) do { unsigned _sp = 0; while (cond) { __builtin_amdgcn_s_sleep(1); \
    if ((++_sp & 255u) == 0u) { if (xb_ld(&(bar)[XB_TMO])) break; if (_sp > XB_SPIN_CAP) { atomicAdd(&(bar)[XB_TMO], 1u); break; } } } } while (0)

struct XcdBarrier {
    unsigned* bar; unsigned x;
    volatile LAS unsigned* st;
};

__device__ __forceinline__ XcdBarrier xcd_barrier_post(unsigned* bar, volatile LAS unsigned* st) {
    XcdBarrier b; b.bar = bar; b.x = xb_xcc_id(); b.st = st;
    if (threadIdx.x == 0) (void)xb_add(&bar[XB_XCNT(b.x)], 1u);
    return b;
}
__device__ __forceinline__ void xcd_barrier_complete(unsigned* bar, unsigned x, unsigned& nloc, unsigned& nx) {
    const unsigned G = gridDim.x * gridDim.y * gridDim.z;
    unsigned sum, cnt, mine, sp = 0u;
    for (;;) {
        sum = 0u; cnt = 0u; mine = 0u;
#pragma unroll
        for (unsigned j = 0; j < 16; ++j) { const unsigned c = xb_ld(&bar[XB_XCNT(j)]); sum += c; cnt += (c > 0u) ? 1u : 0u; mine = (j == x) ? c : mine; }
        if (sum == G) break;
        __builtin_amdgcn_s_sleep(1);
        if ((++sp & 255u) == 0u) { if (xb_ld(&bar[XB_TMO])) break; if (sp > XB_SPIN_CAP) { atomicAdd(&bar[XB_TMO], 1u); break; } }
    }
    nloc = mine > 0u ? mine : 1u; nx = cnt > 0u ? cnt : 1u;
}

__device__ __forceinline__ void xcd_barrier(const XcdBarrier& b) {
    asm volatile("s_waitcnt vmcnt(0)" ::: "memory");
    __syncthreads();
    if (threadIdx.x == 0) {
        unsigned* bar = b.bar;
        __builtin_amdgcn_s_waitcnt(0);
        unsigned nloc = b.st[0], nx = b.st[1];
        if (nloc == 0u) { xcd_barrier_complete(bar, b.x, nloc, nx); b.st[0] = nloc; b.st[1] = nx; }
        const unsigned old = xb_add(&bar[XB_XSUB(b.x)], 1u);
        const unsigned gen = old / nloc;
        if (old + 1u == (gen + 1u) * nloc) {
            __builtin_amdgcn_fence(__ATOMIC_RELEASE, "agent");
            asm volatile("s_waitcnt vmcnt(0)" ::: "memory");
            const unsigned og = xb_add(&bar[XB_TOP], 1u);
            const unsigned tg = og / nx;
            if (og + 1u == (tg + 1u) * nx) xb_add(&bar[XB_TOPGEN], 1u);
            else XB_SPIN(xb_ld(&bar[XB_TOPGEN]) == tg, bar);
            __builtin_amdgcn_fence(__ATOMIC_ACQUIRE, "agent");
            xb_add(&bar[XB_XGEN(b.x)], 1u);
            asm volatile("s_waitcnt vmcnt(0)" ::: "memory");
        } else {
            XB_SPIN(xb_ld(&bar[XB_XGEN(b.x)]) == gen, bar);
            __builtin_amdgcn_fence(__ATOMIC_ACQUIRE, "agent");
            asm volatile("s_waitcnt vmcnt(0)" ::: "memory");
        }
    }
    __syncthreads();
}


constexpr int D = 1024, DFF = 2816;
constexpr int M_P = 8 * 4096, M_S = 32 * 2048, MT = M_P + M_S;
constexpr int ZLD0 = 1536, ZLD1 = 1280;
constexpr float RMS_EPS = 1e-6f;
constexpr float NEGBIG = -1e30f;

constexpr size_t MiB = 1u << 20;
constexpr size_t WS_BAR = 16384;
constexpr size_t WS_CTR = 0;
constexpr size_t WS_TB = 1 * MiB;
constexpr size_t WS_W1 = 2 * MiB;
constexpr size_t WS_W2 = 46 * MiB;
constexpr size_t WS_WINE = 68 * MiB;
constexpr size_t WS_WVE = 71 * MiB;
constexpr size_t WS_WGLU = 72 * MiB;
constexpr size_t WS_WOE = 73 * MiB;
constexpr size_t WS_WINO = 75 * MiB;
constexpr size_t WS_WVO = 78 * MiB;
constexpr size_t WS_WOO = 79 * MiB;
constexpr size_t WS_SSQ = 84 * MiB;
constexpr size_t WS_XN = 96 * MiB;
constexpr size_t OUT_G = 0, OUT_YB = 96 * MiB, OUT_SSQ = 192 * MiB;
constexpr size_t WS_HZ = 288 * MiB;
constexpr size_t WS_Z = WS_HZ, WS_VT = WS_HZ + 288 * MiB, WS_YF = WS_HZ + 384 * MiB;
constexpr size_t WS_MIX = 816 * MiB;
constexpr size_t WS_END = 1008 * MiB;

constexpr int LDS_BYTES = 131072 + 4096 + 4096 + 64;
constexpr int NTHREADS = 512;

struct Params { const float* in[25]; float* out; unsigned char* ws; };
#define CAS __attribute__((address_space(4)))
struct PP {
    const CAS unsigned char* ka;
    __device__ __forceinline__ const float* in(int k) const { return *(const float* const CAS*)(ka + 8 * k); }
    __device__ __forceinline__ float* out() const { return *(float* const CAS*)(ka + 8 * 25); }
    __device__ __forceinline__ unsigned char* ws() const { return *(unsigned char* const CAS*)(ka + 8 * 26); }
};

__device__ __forceinline__ unsigned f2bf(float f) { unsigned u = __builtin_bit_cast(unsigned, f); return (u + 0x7fffu + ((u >> 16) & 1u)) >> 16; }
__device__ __forceinline__ unsigned pk2(float lo, float hi) { return f2bf(lo) | (f2bf(hi) << 16); }
__device__ __forceinline__ float bflo(unsigned w) { return __uint_as_float(w << 16); }
__device__ __forceinline__ float bfhi(unsigned w) { return __uint_as_float(w & 0xffff0000u); }
__device__ __forceinline__ float wave_sum(float v) {
#pragma unroll
    for (int o = 1; o < 64; o <<= 1) v += __shfl_xor(v, o);
    return v;
}
#define LDS_WAIT() asm volatile("s_waitcnt lgkmcnt(0)" ::: "memory")
#define CFENCE() asm volatile("" ::: "memory")

__device__ __forceinline__ void tr_item(const float* W, int ldw, int K, int k0, int nsrc, bf16_t* WT, int drow, const float* gain, LAS float* scr, int lane) {
    float wv[32];
#pragma unroll
    for (int i = 0; i < 32; ++i) { const int kk = 2 * i + (lane >> 5); wv[i] = W[(size_t)(k0 + kk) * ldw + nsrc + (lane & 31)]; }
#pragma unroll
    for (int i = 0; i < 32; ++i) { const int kk = 2 * i + (lane >> 5); const float gk = gain ? gain[k0 + kk] : 1.0f; scr[kk * 33 + (lane & 31)] = wv[i] * gk; }
    LDS_WAIT();
    const int c = lane & 7;
#pragma unroll
    for (int j = 0; j < 4; ++j) { const int n = (lane >> 3) + 8 * j; const LAS float* s = scr + (8 * c) * 33 + n;
        u32x4 o; o.x = pk2(s[0 * 33], s[1 * 33]); o.y = pk2(s[2 * 33], s[3 * 33]); o.z = pk2(s[4 * 33], s[5 * 33]); o.w = pk2(s[6 * 33], s[7 * 33]);
        *(u32x4*)(WT + (size_t)(drow + n) * K + k0 + 8 * c) = o; }
    LDS_WAIT();
}
__device__ __forceinline__ void tr_job(int r, const float* W, int ldw, int K, int ncol0, int ncols, bf16_t* WT, int ilv, const float* gain, LAS float* scr, int lane) {
    const int nblk = ncols >> 5, kb = r / nblk, nb = r - kb * nblk, n0 = nb * 32;
    const int drow = ilv ? ((n0 >> 7) * 256 + (n0 & 127) + (ilv == 2 ? 128 : 0)) : n0;
    tr_item(W, ldw, K, 64 * kb, ncol0 + n0, WT, drow, gain, scr, lane);
}
__device__ __forceinline__ void prologue_weights(const PP P, LAS float* scr, int gw, int ngw, int lane) {
    unsigned char* ws = P.ws();
    constexpr int I_F = 1408;
    constexpr int N_FFN = 12 * I_F;
    constexpr int I_INE = 16 * 48, I_VE = 16 * 16, I_GLU = 8 * 16, I_OE = 16 * 32, I_INO = 16 * 40, I_VO = 16 * 8, I_OO = 16 * 32;
    constexpr int NITEMS = N_FFN + I_INE + I_VE + I_GLU + I_OE + I_INO + I_VO + I_OO;
    for (int it = gw; it < NITEMS; it += ngw) {
        int r = it;
        if (r < N_FFN) {
            const int f = r / (3 * I_F); int rr = r - f * 3 * I_F; const int which = rr / I_F; rr -= which * I_F;
            if (which == 0)      tr_job(rr, P.in(3) + (size_t)f * D * DFF, DFF, D, 0, DFF, (bf16_t*)(ws + WS_W1) + (size_t)f * 2 * DFF * D, 1, P.in(2) + f * D, scr, lane);
            else if (which == 1) tr_job(rr, P.in(4) + (size_t)f * D * DFF, DFF, D, 0, DFF, (bf16_t*)(ws + WS_W1) + (size_t)f * 2 * DFF * D, 2, P.in(2) + f * D, scr, lane);
            else                 tr_job(rr, P.in(5) + (size_t)f * DFF * D, D, DFF, 0, D, (bf16_t*)(ws + WS_W2) + (size_t)f * D * DFF, 0, nullptr, scr, lane);
            continue;
        }
        r -= N_FFN;
        if (r < I_INE) { tr_job(r, P.in(7), 2048, D, 0, 1536, (bf16_t*)(ws + WS_WINE), 0, P.in(6), scr, lane); continue; } r -= I_INE;
        if (r < I_VE)  { tr_job(r, P.in(7), 2048, D, 1536, 512, (bf16_t*)(ws + WS_WVE), 0, P.in(6), scr, lane); continue; } r -= I_VE;
        if (r < I_GLU) { tr_job(r, P.in(16), 512, 512, 0, 512, (bf16_t*)(ws + WS_WGLU), 0, nullptr, scr, lane); continue; } r -= I_GLU;
        if (r < I_OE)  { tr_job(r, P.in(19), D, D, 0, D, (bf16_t*)(ws + WS_WOE), 0, nullptr, scr, lane); continue; } r -= I_OE;
        if (r < I_INO) { tr_job(r, P.in(20), 1536, D, 0, 1280, (bf16_t*)(ws + WS_WINO), 0, P.in(6) + D, scr, lane); continue; } r -= I_INO;
        if (r < I_VO)  { tr_job(r, P.in(20), 1536, D, 1280, 256, (bf16_t*)(ws + WS_WVO), 0, P.in(6) + D, scr, lane); continue; } r -= I_VO;
        tr_job(r, P.in(22), D, D, 0, D, (bf16_t*)(ws + WS_WOO), 0, nullptr, scr, lane);
    }
}
__device__ __forceinline__ int t5_bucket(int rel) {
    const int n = rel < 0 ? -rel : rel;
    int b;
    if (n < 8) b = n;
    else { b = 8 + (n >= 12) + (n >= 16) + (n >= 23) + (n >= 32) + (n >= 46) + (n >= 64) + (n >= 91) + (n >= 128); if (b > 15) b = 15; }
    return b + (rel > 0 ? 16 : 0);
}
__device__ __forceinline__ void prologue_tables(const PP P, int tid) {
    if (blockIdx.x == 0) {
        float* tb = (float*)(P.ws() + WS_TB);
        for (int i = tid; i < 16 * 257; i += NTHREADS) { const int h = i / 257, ri = i - h * 257; tb[i] = P.in(23)[t5_bucket(ri - 128) * 16 + h]; }
    }
}

__device__ __forceinline__ void rms_pass(const PP P, const float* gain, int mode, int gw, int ngw, int lane) {
    bf16_t* XN = (bf16_t*)(P.ws() + WS_XN);
    if (mode == 0) {
        for (int m0 = gw; m0 < MT; m0 += 2 * ngw) {
            f32x4 v[2][4];
#pragma unroll
            for (int rr = 0; rr < 2; ++rr) { const int m = m0 + rr * ngw < MT ? m0 + rr * ngw : m0;
                const float* src = m < M_P ? P.in(0) + (size_t)m * D : P.in(1) + (size_t)(m - M_P) * D;
                const f32x4* xr = (const f32x4*)src + lane;
#pragma unroll
                for (int j = 0; j < 4; ++j) v[rr][j] = xr[64 * j]; }
#pragma unroll
            for (int rr = 0; rr < 2; ++rr) { const int m = m0 + rr * ngw; if (m >= MT) break;
                float ss = 0.f;
#pragma unroll
                for (int j = 0; j < 4; ++j) ss += (v[rr][j].x * v[rr][j].x + v[rr][j].y * v[rr][j].y) + (v[rr][j].z * v[rr][j].z + v[rr][j].w * v[rr][j].w);
                const float sst = wave_sum(ss);
                if (lane < 16) ((float*)((unsigned char*)P.out() + OUT_SSQ))[(size_t)m * 16 + lane] = lane == 0 ? sst : 0.f;
                u32x2* o8 = (u32x2*)(XN + (size_t)m * D) + lane;
#pragma unroll
                for (int j = 0; j < 4; ++j) { u32x2 w; w.x = pk2(v[rr][j].x, v[rr][j].y); w.y = pk2(v[rr][j].z, v[rr][j].w); o8[64 * j] = w; } }
        }
    } else {
        f32x4 gv[4];
#pragma unroll
        for (int j = 0; j < 4; ++j) gv[j] = ((const f32x4*)gain)[lane + 64 * j];
        for (int m0 = gw; m0 < MT; m0 += 2 * ngw) {
            u32x2 w[2][4];
#pragma unroll
            for (int rr = 0; rr < 2; ++rr) { const int m = m0 + rr * ngw < MT ? m0 + rr * ngw : m0; const u32x2* xr = (const u32x2*)(XN + (size_t)m * D) + lane;
#pragma unroll
                for (int j = 0; j < 4; ++j) w[rr][j] = xr[64 * j]; }
#pragma unroll
            for (int rr = 0; rr < 2; ++rr) { const int m = m0 + rr * ngw; if (m >= MT) break;
                f32x4 v[4]; float ss = 0.f;
#pragma unroll
                for (int j = 0; j < 4; ++j) { v[j] = (f32x4){bflo(w[rr][j].x), bfhi(w[rr][j].x), bflo(w[rr][j].y), bfhi(w[rr][j].y)}; ss += (v[j].x * v[j].x + v[j].y * v[j].y) + (v[j].z * v[j].z + v[j].w * v[j].w); }
                const float rstd = 1.0f / sqrtf(wave_sum(ss) * (1.0f / D) + RMS_EPS);
                f32x4* xo = (f32x4*)(P.out() + (size_t)m * D) + lane;
#pragma unroll
                for (int j = 0; j < 4; ++j) __builtin_nontemporal_store(v[j] * rstd * gv[j], xo + 64 * j); }
        }
    }
}

__device__ __forceinline__ int crow(int i, int hi) { return (i & 3) + 8 * (i >> 2) + 4 * hi; }
#define MFMA32(a, b, c) __builtin_amdgcn_mfma_f32_32x32x16_bf16((a), (b), (c), 0, 0, 0)
typedef float f32x2_t __attribute__((ext_vector_type(2))); typedef __bf16 bf16x2_t __attribute__((ext_vector_type(2)));
__device__ __forceinline__ unsigned cvtpk_s(float lo, float hi) { f32x2_t v = {lo, hi}; bf16x2_t r = __builtin_convertvector(v, bf16x2_t); return __builtin_bit_cast(unsigned, r); }
constexpr int SST_PITCH = 272;
constexpr int SST_BYTES = 16 * SST_PITCH;
__device__ __forceinline__ unsigned cvtpk(float lo, float hi) { unsigned r; asm volatile("v_cvt_pk_bf16_f32 %0, %1, %2" : "=v"(r) : "v"(lo), "v"(hi)); return r; }
template <int DIR> __device__ __forceinline__ void s5_task2(const PP P, int sA, int sB, int g, LAS unsigned char* wl, int lane) {
    constexpr int dir = DIR;
    const int pl = lane & 31, h = lane >> 5;
    const int L = sA < 8 ? 4096 : 2048;
    const size_t rowA = sA < 8 ? (size_t)sA * 4096 : (size_t)M_P + (size_t)(sA - 8) * 2048;
    const size_t rowB = sB < 8 ? (size_t)sB * 4096 : (size_t)M_P + (size_t)(sB - 8) * 2048;
    const int dg = dir * 32 + g;
    const bf16_t* Z = (const bf16_t*)(P.ws() + WS_Z);
    bf16_t* Y = dir ? (bf16_t*)((unsigned char*)P.out() + OUT_YB) : (bf16_t*)(P.ws() + WS_YF);
    float are[2], aim[2];
    bf16x8 bfr[4];
#pragma unroll
    for (int st = 0; st < 2; ++st) {
        const int p = st * 32 + pl;
        const float lre = P.in(8)[dg * 64 + p], lim = P.in(9)[dg * 64 + p], dt = expf(P.in(10)[dg]);
        const float xr = lre * dt, th = lim * dt;
        const float mag = expf(xr), em1 = expm1f(xr), sn = sinf(th), cs_ = cosf(th), sh = sinf(0.5f * th);
        const float abr = mag * cs_, abi = mag * sn;
        const float nr = em1 * cs_ - 2.0f * sh * sh;
        const float den = lre * lre + lim * lim;
        const float cr = (nr * lre + abi * lim) / den, ci = (abi * lre - nr * lim) / den;
        are[st] = abr; aim[st] = abi;
        const float* br = P.in(11) + (size_t)(dg * 64 + p) * 16 + 8 * h;
        const float* bi = P.in(12) + (size_t)(dg * 64 + p) * 16 + 8 * h;
        const f32x4 r0 = *(const f32x4*)br, r1 = *(const f32x4*)(br + 4), i0 = *(const f32x4*)bi, i1 = *(const f32x4*)(bi + 4);
        float vr[8], vi[8];
#pragma unroll
        for (int j = 0; j < 4; ++j) {
            vr[j] = cr * r0[j] - ci * i0[j]; vi[j] = cr * i0[j] + ci * r0[j];
            vr[4 + j] = cr * r1[j] - ci * i1[j]; vi[4 + j] = cr * i1[j] + ci * r1[j];
        }
        u32x4 wr_, wi_;
        wr_.x = pk2(vr[0], vr[1]); wr_.y = pk2(vr[2], vr[3]); wr_.z = pk2(vr[4], vr[5]); wr_.w = pk2(vr[6], vr[7]);
        wi_.x = pk2(vi[0], vi[1]); wi_.y = pk2(vi[2], vi[3]); wi_.z = pk2(vi[4], vi[5]); wi_.w = pk2(vi[6], vi[7]);
        bfr[2 * st] = __builtin_bit_cast(bf16x8, wr_); bfr[2 * st + 1] = __builtin_bit_cast(bf16x8, wi_);
    }
    const int cc = lane & 15, q = lane >> 4;
    bf16x8 cf[4];
#pragma unroll
    for (int kb = 0; kb < 4; ++kb) {
        float v[8];
#pragma unroll
        for (int j = 0; j < 8; ++j) {
            const int kp = kb * 32 + q * 8 + j, plp = kp >> 2, part = kp & 3, p = (part >> 1) * 32 + plp;
            const size_t ci_ = (size_t)(dg * 16 + cc) * 64 + p;
            v[j] = (part & 1) ? -P.in(14)[ci_] : P.in(13)[ci_];
        }
        u32x4 w; w.x = pk2(v[0], v[1]); w.y = pk2(v[2], v[3]); w.z = pk2(v[4], v[5]); w.w = pk2(v[6], v[7]);
        cf[kb] = __builtin_bit_cast(bf16x8, w);
    }
    float sre0 = 0.f, sim0 = 0.f, sre1 = 0.f, sim1 = 0.f;
    const int nblk = L / 16;
    const int ar = lane & 31, ahr = (ar >> 2) & 1, ai_ = (ar & 3) + 4 * (ar >> 3), atau = dir ? 15 - ai_ : ai_;
    const bf16_t* ubase = Z + ((ahr ? rowB : rowA) + atau) * ZLD0 + g * 16 + 8 * h;
    bf16x8 unext[4];
#pragma unroll
    for (int k = 0; k < 4; ++k) { const int tb_ = dir ? (nblk - 1 - k) * 16 : k * 16; unext[k] = *(const bf16x8*)(ubase + (size_t)tb_ * ZLD0); }
    LAS unsigned char* sst = wl + h * SST_BYTES;
    const size_t rowH = h ? rowB : rowA;
    for (int blk4 = 0; blk4 < nblk; blk4 += 4) {
        bf16x8 ucur4[4];
#pragma unroll
        for (int k = 0; k < 4; ++k) ucur4[k] = unext[k];
        if (blk4 + 4 < nblk) {
#pragma unroll
            for (int k = 0; k < 4; ++k) { const int bn = blk4 + 4 + k; const int tb_ = dir ? (nblk - 1 - bn) * 16 : bn * 16; unext[k] = *(const bf16x8*)(ubase + (size_t)tb_ * ZLD0); }
        }
#pragma unroll
        for (int k = 0; k < 4; ++k) {
        const int blk = blk4 + k;
        const int tb = dir ? (nblk - 1 - blk) * 16 : blk * 16;
        const bf16x8 ucur = ucur4[k];
        f32x16 bu0 = {}, bu1 = {}, bu2 = {}, bu3 = {};
        bu0 = MFMA32(ucur, bfr[0], bu0); bu1 = MFMA32(ucur, bfr[1], bu1); bu2 = MFMA32(ucur, bfr[2], bu2); bu3 = MFMA32(ucur, bfr[3], bu3);
#pragma unroll
        for (int i = 0; i < 16; ++i) {
            const float n0r = fmaf(are[0], sre0, fmaf(-aim[0], sim0, bu0[i])), n0i = fmaf(are[0], sim0, fmaf(aim[0], sre0, bu1[i]));
            sre0 = n0r; sim0 = n0i;
            asm volatile("" : "+v"(sre0), "+v"(sim0));
            const float n1r = fmaf(are[1], sre1, fmaf(-aim[1], sim1, bu2[i])), n1i = fmaf(are[1], sim1, fmaf(aim[1], sre1, bu3[i]));
            sre1 = n1r; sim1 = n1i;
            asm volatile("" : "+v"(sre1), "+v"(sim1));
            const int tau = dir ? 15 - i : i;
            u32x2 w; w.x = cvtpk_s(sre0, sim0); w.y = cvtpk_s(sre1, sim1);
            *(LAS u32x2*)(sst + tau * SST_PITCH + pl * 8) = w;
        }
        CFENCE();
#pragma unroll
        for (int sq = 0; sq < 2; ++sq) {
            f32x4 acc = {0.f, 0.f, 0.f, 0.f};
#pragma unroll
            for (int kb = 0; kb < 4; ++kb) {
                const bf16x8 a = *(const LAS bf16x8*)(wl + sq * SST_BYTES + cc * SST_PITCH + (kb * 32 + q * 8) * 2);
                acc = __builtin_amdgcn_mfma_f32_16x16x32_bf16(cf[kb], a, acc, 0, 0, 0);
            }
            bf16_t* yp = Y + ((sq ? rowB : rowA) + tb + cc) * 512 + g * 16 + q * 4;
            u32x2 yw; yw.x = cvtpk_s(acc[0], acc[1]); yw.y = cvtpk_s(acc[2], acc[3]);
            *(u32x2*)yp = yw;
        }
        CFENCE();
        }
    }
    (void)rowH;
}
__device__ __forceinline__ void s5_combine(const PP P, int gtid, int ngt) {
    const bf16_t* Z = (const bf16_t*)(P.ws() + WS_Z); const bf16_t* YF = (const bf16_t*)(P.ws() + WS_YF); const bf16_t* YB = (const bf16_t*)((unsigned char*)P.out() + OUT_YB);
    bf16_t* G = (bf16_t*)((unsigned char*)P.out() + OUT_G);
    const float* Dk = P.in(15);
    for (int e0 = gtid; e0 < MT * 64; e0 += 2 * ngt) {
        u32x4 uw2[2], fw2[2], bw2[2];
#pragma unroll
        for (int rr = 0; rr < 2; ++rr) { const int e = e0 + rr * ngt < MT * 64 ? e0 + rr * ngt : e0; const int m = e >> 6, c8 = (e & 63) * 8;
            uw2[rr] = *(const u32x4*)(Z + (size_t)m * ZLD0 + c8); fw2[rr] = *(const u32x4*)(YF + (size_t)m * 512 + c8); bw2[rr] = *(const u32x4*)(YB + (size_t)m * 512 + c8); }
#pragma unroll
        for (int rr = 0; rr < 2; ++rr) {
        const int e = e0 + rr * ngt; if (e >= MT * 64) break;
        const int m = e >> 6, c8 = (e & 63) * 8;
        const u32x4 uw = uw2[rr], fw = fw2[rr], bw = bw2[rr];
        const f32x4 d0 = *(const f32x4*)(Dk + c8), d1 = *(const f32x4*)(Dk + c8 + 4);
        float y[8];
        y[0] = d0.x * bflo(uw.x) + bflo(fw.x) + bflo(bw.x); y[1] = d0.y * bfhi(uw.x) + bfhi(fw.x) + bfhi(bw.x);
        y[2] = d0.z * bflo(uw.y) + bflo(fw.y) + bflo(bw.y); y[3] = d0.w * bfhi(uw.y) + bfhi(fw.y) + bfhi(bw.y);
        y[4] = d1.x * bflo(uw.z) + bflo(fw.z) + bflo(bw.z); y[5] = d1.y * bfhi(uw.z) + bfhi(fw.z) + bfhi(bw.z);
        y[6] = d1.z * bflo(uw.w) + bflo(fw.w) + bflo(bw.w); y[7] = d1.w * bfhi(uw.w) + bfhi(fw.w) + bfhi(bw.w);
#pragma unroll
        for (int j = 0; j < 8; ++j) { const float v = y[j], t = 0.7978845608028654f * (v + 0.044715f * v * v * v); y[j] = v * __builtin_amdgcn_rcpf(1.0f + __expf(-2.0f * t)); }
        u32x4 w; w.x = pk2(y[0], y[1]); w.y = pk2(y[2], y[3]); w.z = pk2(y[4], y[5]); w.w = pk2(y[6], y[7]);
        *(u32x4*)(G + (size_t)m * 512 + c8) = w;
        }
    }
}

__device__ __forceinline__ void softmax_pv(f32x16& sc, float& m, float& l, f32x16& o0, f32x16& o1, const s16x4 (&v)[2][2][2]) {
    float tm = sc[0];
#pragma unroll
    for (int i = 1; i < 16; ++i) tm = fmaxf(tm, sc[i]);
    tm = fmaxf(tm, __shfl_xor(tm, 32));
    const float mn = fmaxf(m, tm), alpha = __expf(m - mn);
    float ps = 0.f;
#pragma unroll
    for (int i = 0; i < 16; ++i) { const float pv = sc[i] > -1e29f ? __expf(sc[i] - mn) : 0.f; sc[i] = pv; ps += pv; }
    l = l * alpha + ps; m = mn;
#pragma unroll
    for (int i = 0; i < 16; ++i) { o0[i] *= alpha; o1[i] *= alpha; }
    u32x4 w0, w1;
    w0.x = pk2(sc[0], sc[1]); w0.y = pk2(sc[2], sc[3]); w0.z = pk2(sc[4], sc[5]); w0.w = pk2(sc[6], sc[7]);
    w1.x = pk2(sc[8], sc[9]); w1.y = pk2(sc[10], sc[11]); w1.z = pk2(sc[12], sc[13]); w1.w = pk2(sc[14], sc[15]);
    const bf16x8 pf0 = __builtin_bit_cast(bf16x8, w0), pf1 = __builtin_bit_cast(bf16x8, w1);
#define VFR(dh, s) (bf16x8){v[dh][s][0][0], v[dh][s][0][1], v[dh][s][0][2], v[dh][s][0][3], v[dh][s][1][0], v[dh][s][1][1], v[dh][s][1][2], v[dh][s][1][3]}
    o0 = MFMA32(VFR(0, 0), pf0, o0); o0 = MFMA32(VFR(0, 1), pf1, o0);
    o1 = MFMA32(VFR(1, 0), pf0, o1); o1 = MFMA32(VFR(1, 1), pf1, o1);
#undef VFR
}
__device__ __forceinline__ void attn_store(bf16_t* op  , const f32x16& o0, const f32x16& o1, float inv) {
#pragma unroll
    for (int a = 0; a < 4; ++a) {
        u32x2 w; w.x = pk2(o0[4 * a] * inv, o0[4 * a + 1] * inv); w.y = pk2(o0[4 * a + 2] * inv, o0[4 * a + 3] * inv); *(u32x2*)(op + 8 * a) = w;
        u32x2 x; x.x = pk2(o1[4 * a] * inv, o1[4 * a + 1] * inv); x.y = pk2(o1[4 * a + 2] * inv, o1[4 * a + 3] * inv); *(u32x2*)(op + 32 + 8 * a) = x;
    }
}
__device__ __forceinline__ void gqa_task(const PP P, int idx, LAS float* tbl, int lane) {
    const int hh = idx & 3, kvg = (idx >> 2) & 3, tb32 = idx >> 4, head = kvg * 4 + hh;
    const int m0 = tb32 * 32;
    int row0, L; if (m0 < M_P) { row0 = m0 & ~4095; L = 4096; } else { row0 = M_P + ((m0 - M_P) & ~2047); L = 2048; }
    const int qpos0 = m0 - row0, r32 = lane & 31, hi = lane >> 5;
    const bf16_t* Z = (const bf16_t*)(P.ws() + WS_Z); const bf16_t* VT = (const bf16_t*)(P.ws() + WS_VT); bf16_t* MIX = (bf16_t*)(P.ws() + WS_MIX);
    const float* tbg = (const float*)(P.ws() + WS_TB) + head * 257;
    for (int i = lane; i < 257; i += 64) tbl[i] = tbg[i];
    const bf16_t* qp = Z + (size_t)(m0 + r32) * ZLD1 + head * 64 + hi * 8;
    bf16x8 qr[4];
#pragma unroll
    for (int ds = 0; ds < 4; ++ds) qr[ds] = *(const bf16x8*)(qp + ds * 16);
    float m = P.in(21)[head], l = hi ? 0.f : 1.f;
    f32x16 o0 = {}, o1 = {};
    const int qpos = qpos0 + r32;
    for (int kt = 0; kt < 9; ++kt) {
        const int kp0 = qpos0 - 128 + kt * 32;
        if (kp0 < 0 || kp0 >= L) continue;
        const bf16_t* kptr = Z + (size_t)(row0 + kp0 + r32) * ZLD1 + 1024 + kvg * 64 + hi * 8;
        bf16x8 kf[4];
#pragma unroll
        for (int ds = 0; ds < 4; ++ds) kf[ds] = *(const bf16x8*)(kptr + ds * 16);
        const bf16_t* vptr = VT + (size_t)(kvg * 64 + r32) * MT + row0 + kp0 + hi * 4;
        s16x4 v[2][2][2];
#pragma unroll
        for (int dh = 0; dh < 2; ++dh)
#pragma unroll
            for (int s = 0; s < 2; ++s) { v[dh][s][0] = *(const s16x4*)(vptr + (size_t)dh * 32 * MT + s * 16); v[dh][s][1] = *(const s16x4*)(vptr + (size_t)dh * 32 * MT + s * 16 + 8); }
        f32x16 sc = {};
#pragma unroll
        for (int ds = 0; ds < 4; ++ds) sc = MFMA32(kf[ds], qr[ds], sc);
#pragma unroll
        for (int i = 0; i < 16; ++i) {
            const int rel = kp0 + crow(i, hi) - qpos;
            const bool valid = rel >= -128 && rel <= 128;
            const int ri = (rel < -128 ? -128 : (rel > 128 ? 128 : rel)) + 128;
            const float b = tbl[ri];
            sc[i] = valid ? sc[i] * 0.125f + b : NEGBIG;
        }
        softmax_pv(sc, m, l, o0, o1, v);
    }
    l += __shfl_xor(l, 32);
    attn_store(MIX + (size_t)(m0 + r32) * D + head * 64 + 4 * hi, o0, o1, 1.0f / l);
}
constexpr float LOG2E = 1.4426950408889634f;
__device__ __forceinline__ void softmax2_pv(f32x16& sc, float& m, float& l, f32x16& o0, f32x16& o1, const bf16x8 (&vf)[2][2]) {
    float tm = fmaxf(fmaxf(sc[0], sc[1]), fmaxf(sc[2], sc[3]));
#pragma unroll
    for (int i = 4; i < 16; i += 4) tm = fmaxf(tm, fmaxf(fmaxf(sc[i], sc[i + 1]), fmaxf(sc[i + 2], sc[i + 3])));
    tm = fmaxf(tm, __shfl_xor(tm, 32));
    const float mn = fmaxf(m, tm);
    if (__builtin_amdgcn_ballot_w64(mn > m)) {
        const float alpha = __builtin_amdgcn_exp2f(m - mn);
        l *= alpha;
#pragma unroll
        for (int i = 0; i < 16; ++i) { o0[i] *= alpha; o1[i] *= alpha; }
        m = mn;
    }
    float ps = 0.f;
#pragma unroll
    for (int i = 0; i < 16; ++i) { const float pv = __builtin_amdgcn_exp2f(sc[i] - m); sc[i] = pv; ps += pv; }
    l += ps;
    u32x4 w0, w1;
    w0.x = cvtpk_s(sc[0], sc[1]); w0.y = cvtpk_s(sc[2], sc[3]); w0.z = cvtpk_s(sc[4], sc[5]); w0.w = cvtpk_s(sc[6], sc[7]);
    w1.x = cvtpk_s(sc[8], sc[9]); w1.y = cvtpk_s(sc[10], sc[11]); w1.z = cvtpk_s(sc[12], sc[13]); w1.w = cvtpk_s(sc[14], sc[15]);
    const bf16x8 pf0 = __builtin_bit_cast(bf16x8, w0), pf1 = __builtin_bit_cast(bf16x8, w1);
    o0 = MFMA32(vf[0][0], pf0, o0); o0 = MFMA32(vf[0][1], pf1, o0);
    o1 = MFMA32(vf[1][0], pf0, o1); o1 = MFMA32(vf[1][1], pf1, o1);
}
constexpr int GK_PITCH = 144, GV_PITCH = 776, GQ_K = 0, GQ_V = 384 * GK_PITCH, GQ_TBL = GQ_V + 64 * GV_PITCH, GQ_TBL_W = 1040;
static_assert(GQ_TBL + 8 * GQ_TBL_W <= 131072, "gqa lds");
__device__ __forceinline__ void gqa_phase(const PP P, LAS unsigned char* lds, int tid, int cb, int G) {
    const int lane = tid & 63, wave = __builtin_amdgcn_readfirstlane(tid >> 6), r32 = lane & 31, hi = lane >> 5;
    const bf16_t* Z = (const bf16_t*)(P.ws() + WS_Z); const bf16_t* VT = (const bf16_t*)(P.ws() + WS_VT); bf16_t* MIX = (bf16_t*)(P.ws() + WS_MIX);
    LAS float* tbl = (LAS float*)(lds + GQ_TBL + wave * GQ_TBL_W);
    u32x4 kreg[6], vreg[6];
#define GQA_LOAD(unit_) do { const int kvg_ = (unit_) & 3, m0_ = ((unit_) >> 2) * 128; int row0_, L_; if (m0_ < M_P) { row0_ = m0_ & ~4095; L_ = 4096; } else { row0_ = M_P + ((m0_ - M_P) & ~2047); L_ = 2048; } \
        const int kb_ = m0_ - 128;     \
        _Pragma("unroll") for (int c = 0; c < 6; ++c) { const int id = tid + 512 * c, row = id >> 3, ch = id & 7, tok = kb_ + row; const bool ok = tok >= row0_ && tok < row0_ + L_; \
            kreg[c] = ok ? *(const u32x4*)(Z + (size_t)tok * ZLD1 + 1024 + kvg_ * 64 + ch * 8) : (u32x4){0u, 0u, 0u, 0u}; } \
        _Pragma("unroll") for (int c = 0; c < 6; ++c) { const int id = tid + 512 * c, d = id / 48, ch = id - d * 48, tok = kb_ + ch * 8; const bool ok = tok >= row0_ && tok < row0_ + L_; \
            vreg[c] = ok ? *(const u32x4*)(VT + (size_t)(kvg_ * 64 + d) * MT + tok) : (u32x4){0u, 0u, 0u, 0u}; } } while (0)
    int unit = cb;
    if (unit < 3072) GQA_LOAD(unit);
    for (; unit < 3072; unit += G) {
        __syncthreads();
#pragma unroll
        for (int c = 0; c < 6; ++c) { const int id = tid + 512 * c, row = id >> 3, ch = id & 7; *(LAS u32x4*)(lds + GQ_K + row * GK_PITCH + ch * 16) = kreg[c]; }
#pragma unroll
        for (int c = 0; c < 6; ++c) { const int id = tid + 512 * c, d = id / 48, ch = id - d * 48; LAS u32x2* vp = (LAS u32x2*)(lds + GQ_V + d * GV_PITCH + ch * 16);
            vp[0] = (u32x2){vreg[c].x, vreg[c].y}; vp[1] = (u32x2){vreg[c].z, vreg[c].w}; }
        const int kvg = unit & 3, m0 = (unit >> 2) * 128;
        int row0, L; if (m0 < M_P) { row0 = m0 & ~4095; L = 4096; } else { row0 = M_P + ((m0 - M_P) & ~2047); L = 2048; }
        const int head = kvg * 4 + (wave >> 1);
        { const float* tbg = (const float*)(P.ws() + WS_TB) + head * 257; for (int i = lane; i < 257; i += 64) tbl[i] = tbg[i] * LOG2E; }
        if (unit + G < 3072) GQA_LOAD(unit + G);
        __syncthreads();
        const float sink2 = P.in(21)[head] * LOG2E;
        for (int sub = 0; sub < 2; ++sub) {
            const int qoff = ((wave & 1) * 2 + sub) * 32;
            const bf16_t* qp = Z + (size_t)(m0 + qoff + r32) * ZLD1 + head * 64 + hi * 8;
            bf16x8 qr[4];
#pragma unroll
            for (int ds = 0; ds < 4; ++ds) qr[ds] = *(const bf16x8*)(qp + ds * 16);
            float m = sink2, l = hi ? 0.f : 1.f;
            f32x16 o0 = {}, o1 = {};
            for (int t = 0; t < 9; ++t) {
                const int kr0 = qoff + 32 * t, tok0 = m0 - 128 + kr0;
                if (tok0 < row0 || tok0 >= row0 + L) continue;
                bf16x8 kf[4];
#pragma unroll
                for (int ds = 0; ds < 4; ++ds) kf[ds] = *(const LAS bf16x8*)(lds + GQ_K + (kr0 + r32) * GK_PITCH + (16 * ds + 8 * hi) * 2);
                bf16x8 vf[2][2];
#pragma unroll
                for (int dh = 0; dh < 2; ++dh)
#pragma unroll
                    for (int s = 0; s < 2; ++s) { const LAS s16x4* vp = (const LAS s16x4*)(lds + GQ_V + (dh * 32 + r32) * GV_PITCH + (kr0 + 16 * s + 4 * hi) * 2);
                        const s16x4 a = vp[0], c2 = vp[2]; vf[dh][s] = (bf16x8){a[0], a[1], a[2], a[3], c2[0], c2[1], c2[2], c2[3]}; }
                f32x16 sc = {};
#pragma unroll
                for (int ds = 0; ds < 4; ++ds) sc = MFMA32(kf[ds], qr[ds], sc);
                const int ib = 32 * t - r32 + 4 * hi;
                if (t == 0 || t == 8) {
#pragma unroll
                    for (int i = 0; i < 16; ++i) { const int ix = ib + (i & 3) + 8 * (i >> 2); const bool valid = ix >= 0 && ix <= 256; const float bb = tbl[valid ? ix : 0];
                        sc[i] = valid ? sc[i] * (0.125f * LOG2E) + bb : NEGBIG; }
                } else {
#pragma unroll
                    for (int i = 0; i < 16; ++i) sc[i] = sc[i] * (0.125f * LOG2E) + tbl[ib + (i & 3) + 8 * (i >> 2)];
                }
                softmax2_pv(sc, m, l, o0, o1, vf);
            }
            l += __shfl_xor(l, 32);
            attn_store(MIX + (size_t)(m0 + qoff + r32) * D + head * 64 + 4 * hi, o0, o1, 1.0f / l);
        }
    }
#undef GQA_LOAD
}
__device__ __forceinline__ void na_task(const PP P, int idx, LAS float* tbl, int lane) {
    const int qh = idx & 1, h = (idx >> 1) & 7, R = idx >> 4;
    int r, rows, row0;
    if (R < 512) { r = R & 63; rows = 64; row0 = (R >> 6) * 4096; } else { const int R2 = R - 512; r = R2 & 31; rows = 32; row0 = M_P + (R2 >> 5) * 2048; }
    int rs = r - 4; rs = rs < 0 ? 0 : (rs > rows - 8 ? rows - 8 : rs);
    const int r32 = lane & 31, hi = lane >> 5;
    const int m0 = row0 + r * 64 + qh * 32, cq = qh * 32 + r32;
    int cs = cq - 8; cs = cs < 0 ? 0 : (cs > 48 ? 48 : cs);
    const int kbase = row0 + rs * 64;
    const bf16_t* Z = (const bf16_t*)(P.ws() + WS_Z); const bf16_t* VT = (const bf16_t*)(P.ws() + WS_VT); bf16_t* MIX = (bf16_t*)(P.ws() + WS_MIX);
    const float* rpb = P.in(18) + h * 465;
    for (int i = lane; i < 465; i += 64) tbl[i] = rpb[i];
    const bf16_t* qp = Z + (size_t)(m0 + r32) * ZLD0 + 512 + h * 64 + hi * 8;
    bf16x8 qr[4];
#pragma unroll
    for (int ds = 0; ds < 4; ++ds) qr[ds] = *(const bf16x8*)(qp + ds * 16);
    float m = NEGBIG, l = 0.f;
    f32x16 o0 = {}, o1 = {};
    for (int kt = 0; kt < 16; ++kt) {
        const int kt0 = kbase + kt * 32;
        const bf16_t* kptr = Z + (size_t)(kt0 + r32) * ZLD0 + 1024 + h * 64 + hi * 8;
        bf16x8 kf[4];
#pragma unroll
        for (int ds = 0; ds < 4; ++ds) kf[ds] = *(const bf16x8*)(kptr + ds * 16);
        const bf16_t* vptr = VT + (size_t)(h * 64 + r32) * MT + kt0 + hi * 4;
        s16x4 v[2][2][2];
#pragma unroll
        for (int dh = 0; dh < 2; ++dh)
#pragma unroll
            for (int s = 0; s < 2; ++s) { v[dh][s][0] = *(const s16x4*)(vptr + (size_t)dh * 32 * MT + s * 16); v[dh][s][1] = *(const s16x4*)(vptr + (size_t)dh * 32 * MT + s * 16 + 8); }
        f32x16 sc = {};
#pragma unroll
        for (int ds = 0; ds < 4; ++ds) sc = MFMA32(kf[ds], qr[ds], sc);
        const int rrow = (rs + (kt >> 1) - r + 7) * 31, kc0 = 32 * (kt & 1);
#pragma unroll
        for (int i = 0; i < 16; ++i) {
            const int kc = kc0 + crow(i, hi);
            const bool valid = kc >= cs && kc < cs + 16;
            const int bi = valid ? rrow + (kc - cq + 15) : 0;
            const float b = tbl[bi];
            sc[i] = valid ? sc[i] * 0.125f + b : NEGBIG;
        }
        softmax_pv(sc, m, l, o0, o1, v);
    }
    l += __shfl_xor(l, 32);
    attn_store(MIX + (size_t)(m0 + r32) * D + 512 + h * 64 + 4 * hi, o0, o1, 1.0f / l);
}

constexpr int NAT_COLS = 64, NAT_ROWS = 16;
__device__ __forceinline__ void na_fill_table(const PP P, int h, LAS float* tbl, int lane) {
    const float* rpb = P.in(18) + h * 465;
#pragma unroll
    for (int k = 0; k < 16; ++k) {
        const int e = lane + 64 * k, row = e >> 6, col = e & 63, off = col - 32;
        float v = 0.f;
        if (row == 15) v = NEGBIG;
        else if (off >= -15 && off <= 15) v = rpb[row * 31 + off + 15] * LOG2E;
        tbl[e] = v;
    }
}
__device__ __forceinline__ void na_task3(const PP P, int idx, LAS float* tbl, int lane) {
    const int cbk = idx & 3, h = (idx >> 2) & 7, RP = idx >> 5;
    const int mp = RP * 128;
    int row0, rows; if (mp < M_P) { row0 = mp & ~4095; rows = 64; } else { row0 = M_P + ((mp - M_P) & ~2047); rows = 32; }
    const int r = (mp - row0) >> 6;
    int rs0 = r - 4; rs0 = rs0 < 0 ? 0 : (rs0 > rows - 8 ? rows - 8 : rs0);
    int rs1 = r - 3; rs1 = rs1 < 0 ? 0 : (rs1 > rows - 8 ? rows - 8 : rs1);
    const int nkr = rs1 + 8 - rs0;
    const int r32 = lane & 31, hi = lane >> 5;
    const int c0 = 16 * cbk; int cw = c0 - 8; cw = cw < 0 ? 0 : (cw > 32 ? 32 : cw);
    const int qrow = r + (r32 >> 4), qcol = c0 + (r32 & 15), rsq = (r32 >> 4) ? rs1 : rs0;
    int cs = qcol - 8; cs = cs < 0 ? 0 : (cs > 48 ? 48 : cs);
    const int qtok = row0 + qrow * 64 + qcol;
    const bf16_t* Z = (const bf16_t*)(P.ws() + WS_Z); const bf16_t* VT = (const bf16_t*)(P.ws() + WS_VT); bf16_t* MIX = (bf16_t*)(P.ws() + WS_MIX);
    const bf16_t* qp = Z + (size_t)qtok * ZLD0 + 512 + h * 64 + hi * 8;
    bf16x8 qr[4];
#pragma unroll
    for (int ds = 0; ds < 4; ++ds) qr[ds] = *(const bf16x8*)(qp + ds * 16);
    const int kperm = (r32 & 0x13) | ((r32 & 8) >> 1) | ((r32 & 4) << 1);
    const int kcb = cw + 8 * hi;
    float cm[16];
#pragma unroll
    for (int i = 0; i < 16; ++i) { const int kc = kcb + (i & 7) + 16 * (i >> 3); cm[i] = (kc >= cs && kc < cs + 16) ? 0.f : NEGBIG; }
    const int colix = kcb - qcol + 32;
    float m = -1.0e4f, l = 0.f;
    f32x16 o0 = {}, o1 = {};
    const bf16_t* kbase = Z + (size_t)(row0 + rs0 * 64 + cw + kperm) * ZLD0 + 1024 + h * 64 + hi * 8;
    const bf16_t* vbase = VT + (size_t)(h * 64 + r32) * MT + row0 + rs0 * 64 + cw + hi * 8;
    bf16x8 kf[4]; bf16x8 v[2][2];
#define NA_LOAD(KF, V, t_) do { const bf16_t* kp_ = kbase + (size_t)(t_) * 64 * ZLD0; const bf16_t* vp_ = vbase + (t_) * 64; \
        _Pragma("unroll") for (int ds = 0; ds < 4; ++ds) KF[ds] = *(const bf16x8*)(kp_ + ds * 16); \
        _Pragma("unroll") for (int dh = 0; dh < 2; ++dh) _Pragma("unroll") for (int s = 0; s < 2; ++s) V[dh][s] = *(const bf16x8*)(vp_ + (size_t)dh * 32 * MT + s * 16); } while (0)
    NA_LOAD(kf, v, 0);
    bf16x8 nk[4]; bf16x8 nv[2][2];
    NA_LOAD(nk, nv, 1);
    for (int t = 0; t < nkr; ++t) {
        bf16x8 fk[4]; bf16x8 fv[2][2];
        const int tn = t + 2 < nkr ? t + 2 : nkr - 1;
        NA_LOAD(fk, fv, tn);
        f32x16 sc = {};
#pragma unroll
        for (int ds = 0; ds < 4; ++ds) sc = MFMA32(kf[ds], qr[ds], sc);
        const int kr = rs0 + t;
        const int trow = (kr >= rsq && kr < rsq + 8) ? kr - qrow + 7 : 15;
        const LAS float* tp = tbl + trow * NAT_COLS + colix;
#pragma unroll
        for (int i = 0; i < 16; ++i) sc[i] = (sc[i] * (0.125f * LOG2E) + tp[(i & 7) + 16 * (i >> 3)]) + cm[i];
        softmax2_pv(sc, m, l, o0, o1, v);
#pragma unroll
        for (int ds = 0; ds < 4; ++ds) { kf[ds] = nk[ds]; nk[ds] = fk[ds]; }
#pragma unroll
        for (int dh = 0; dh < 2; ++dh)
#pragma unroll
            for (int s = 0; s < 2; ++s) { v[dh][s] = nv[dh][s]; nv[dh][s] = fv[dh][s]; }
    }
#undef NA_LOAD
    l += __shfl_xor(l, 32);
    attn_store(MIX + (size_t)qtok * D + 512 + h * 64 + 4 * hi, o0, o1, 1.0f / l);
}

__device__ __forceinline__ void na_task4(const PP P, int idx, LAS float* tbl, int lane) {
    const int cbk = idx & 3, h = (idx >> 2) & 7, RQ = idx >> 5;
    const int mp = RQ * 256;
    int row0, rows; if (mp < M_P) { row0 = mp & ~4095; rows = 64; } else { row0 = M_P + ((mp - M_P) & ~2047); rows = 32; }
    const int r = (mp - row0) >> 6;
    int rsv[4];
#pragma unroll
    for (int k = 0; k < 4; ++k) { int x = r + k - 4; rsv[k] = x < 0 ? 0 : (x > rows - 8 ? rows - 8 : x); }
    const int rs0 = rsv[0], nkr = rsv[3] + 8 - rs0;
    const int r32 = lane & 31, hi = lane >> 5, sub = r32 >> 4;
    const int c0 = 16 * cbk; int cw = c0 - 8; cw = cw < 0 ? 0 : (cw > 32 ? 32 : cw);
    const int qcol = c0 + (r32 & 15);
    const int qrowA = r + sub, qrowB = r + 2 + sub, rsqA = sub ? rsv[1] : rsv[0], rsqB = sub ? rsv[3] : rsv[2];
    int cs = qcol - 8; cs = cs < 0 ? 0 : (cs > 48 ? 48 : cs);
    const int qtokA = row0 + qrowA * 64 + qcol, qtokB = qtokA + 128;
    const bf16_t* Z = (const bf16_t*)(P.ws() + WS_Z); const bf16_t* VT = (const bf16_t*)(P.ws() + WS_VT); bf16_t* MIX = (bf16_t*)(P.ws() + WS_MIX);
    bf16x8 qrA[4], qrB[4];
    { const bf16_t* qp = Z + (size_t)qtokA * ZLD0 + 512 + h * 64 + hi * 8;
#pragma unroll
      for (int ds = 0; ds < 4; ++ds) { qrA[ds] = *(const bf16x8*)(qp + ds * 16); qrB[ds] = *(const bf16x8*)(qp + (size_t)128 * ZLD0 + ds * 16); } }
    const int kperm = (r32 & 0x13) | ((r32 & 8) >> 1) | ((r32 & 4) << 1);
    const int kcb = cw + 8 * hi;
    float cm[16];
#pragma unroll
    for (int i = 0; i < 16; ++i) { const int kc = kcb + (i & 7) + 16 * (i >> 3); cm[i] = (kc >= cs && kc < cs + 16) ? 0.f : NEGBIG; }
    const int colix = kcb - qcol + 32;
    float mA = -1.0e4f, lA = 0.f, mB = -1.0e4f, lB = 0.f;
    f32x16 oA0 = {}, oA1 = {}, oB0 = {}, oB1 = {};
    const bf16_t* kbase = Z + (size_t)(row0 + rs0 * 64 + cw + kperm) * ZLD0 + 1024 + h * 64 + hi * 8;
    const bf16_t* vbase = VT + (size_t)(h * 64 + r32) * MT + row0 + rs0 * 64 + cw + hi * 8;
    bf16x8 kf[4], v[2][2];
#define NA_LOAD(KF, V, t_) do { const bf16_t* kp_ = kbase + (size_t)(t_) * 64 * ZLD0; const bf16_t* vp_ = vbase + (t_) * 64; \
        _Pragma("unroll") for (int ds = 0; ds < 4; ++ds) KF[ds] = *(const bf16x8*)(kp_ + ds * 16); \
        _Pragma("unroll") for (int dh = 0; dh < 2; ++dh) _Pragma("unroll") for (int s = 0; s < 2; ++s) V[dh][s] = *(const bf16x8*)(vp_ + (size_t)dh * 32 * MT + s * 16); } while (0)
    NA_LOAD(kf, v, 0);
    const int endA = rsv[1] + 8, begB = rsv[2];
    for (int t = 0; t < nkr; ++t) {
        bf16x8 nk[4], nv[2][2];
        const int tn = t + 1 < nkr ? t + 1 : t;
        NA_LOAD(nk, nv, tn);
        const int kr = rs0 + t;
        if (kr < endA) {
            f32x16 sc = {};
#pragma unroll
            for (int ds = 0; ds < 4; ++ds) sc = MFMA32(kf[ds], qrA[ds], sc);
            const int trow = (kr >= rsqA && kr < rsqA + 8) ? kr - qrowA + 7 : 15;
            const LAS float* tp = tbl + trow * NAT_COLS + colix;
#pragma unroll
            for (int i = 0; i < 16; ++i) sc[i] = (sc[i] * (0.125f * LOG2E) + tp[(i & 7) + 16 * (i >> 3)]) + cm[i];
            softmax2_pv(sc, mA, lA, oA0, oA1, v);
        }
        if (kr >= begB) {
            f32x16 sc = {};
#pragma unroll
            for (int ds = 0; ds < 4; ++ds) sc = MFMA32(kf[ds], qrB[ds], sc);
            const int trow = (kr >= rsqB && kr < rsqB + 8) ? kr - qrowB + 7 : 15;
            const LAS float* tp = tbl + trow * NAT_COLS + colix;
#pragma unroll
            for (int i = 0; i < 16; ++i) sc[i] = (sc[i] * (0.125f * LOG2E) + tp[(i & 7) + 16 * (i >> 3)]) + cm[i];
            softmax2_pv(sc, mB, lB, oB0, oB1, v);
        }
#pragma unroll
        for (int ds = 0; ds < 4; ++ds) kf[ds] = nk[ds];
#pragma unroll
        for (int dh = 0; dh < 2; ++dh)
#pragma unroll
            for (int s = 0; s < 2; ++s) v[dh][s] = nv[dh][s];
    }
#undef NA_LOAD
    lA += __shfl_xor(lA, 32); lB += __shfl_xor(lB, 32);
    attn_store(MIX + (size_t)qtokA * D + 512 + h * 64 + 4 * hi, oA0, oA1, 1.0f / lA);
    attn_store(MIX + (size_t)qtokB * D + 512 + h * 64 + 4 * hi, oB0, oB1, 1.0f / lB);
}

enum { PH_PRO, PH_FFN1, PH_FFN2, PH_RMS, PH_INPROJ, PH_MIX0, PH_COMB, PH_GLU, PH_OUTPROJ, PH_GQA, PH_NOP };
constexpr int NPH = 18;
#ifndef DIS_MASK
#define DIS_MASK 0
#endif
#define EN(t) (!((DIS_MASK >> (t)) & 1))
__constant__ int c_ptype[NPH] = {PH_PRO, PH_FFN1, PH_FFN2, PH_INPROJ, PH_MIX0, PH_COMB, PH_GLU, PH_OUTPROJ, PH_FFN1, PH_FFN2, PH_FFN1, PH_FFN2, PH_INPROJ, PH_GQA, PH_OUTPROJ, PH_FFN1, PH_FFN2, PH_RMS};
__constant__ int c_parg[NPH] = {0, 0, 0, 0, 0, 0, 0, 0, 1, 1, 2, 2, 1, 0, 1, 3, 3, 6};
__constant__ int c_psq[NPH] = {0, 0, 1, 1, 0, 0, 0, 2, 2, 3, 3, 4, 4, 0, 5, 5, 6, 0};

__global__ void __launch_bounds__(NTHREADS, 2) mk_fwd(Params Pk) {
    extern __shared__ __attribute__((aligned(16))) unsigned char lds_raw[];
    cg::grid_group grid = cg::this_grid();
    LAS unsigned char* lds = (LAS unsigned char*)lds_raw;
    const int tid0 = threadIdx.x;
    if (tid0 < 8) ((volatile LAS unsigned*)(lds + 131072))[tid0] = 0u;
    __syncthreads();
    const XcdBarrier xbar = xcd_barrier_post((unsigned*)(Pk.ws + WS_BAR), (volatile LAS unsigned*)(lds + 131072));
    const int G0 = gridDim.x, cb0 = blockIdx.x;

    for (int ph = 0; ph < NPH; ++ph) {
        PP P; P.ka = (const CAS unsigned char*)__builtin_amdgcn_kernarg_segment_ptr();
        asm volatile("" : "+s"(P.ka));
        unsigned char* ws = P.ws();
        int tid = tid0; asm volatile("" : "+v"(tid));
        int G = G0, cb = cb0; asm volatile("" : "+s"(G), "+s"(cb));
        const int lane = tid & 63, wave = __builtin_amdgcn_readfirstlane(tid >> 6);
        const int gw = cb * 8 + wave, ngw = G * 8;
        LAS unsigned char* wl = lds + wave * 16384;
        const int type = c_ptype[ph], arg = c_parg[ph], sqi = c_psq[ph];
        if (type == PH_PRO && EN(PH_PRO)) {
            prologue_weights(P, (LAS float*)wl, gw, ngw, lane);
            prologue_tables(P, tid);
            if (cb == 0 && tid < 8) ((unsigned*)(ws + WS_CTR))[64 * tid] = 0u;
            rms_pass(P, P.in(2), 0, gw, ngw, lane);
        } else if (type == PH_FFN1 && EN(PH_FFN1)) {
            pg8::Gemm g{(const bf16_t*)(ws + WS_XN), (const bf16_t*)(ws + WS_W1) + (size_t)arg * 2 * DFF * D, MT, 2 * DFF, D};
            pg8::StaticOrder S; S.init(MT, 2 * DFF, G, cb);
            if (tid < 8) ((LAS int*)(lds + 131072 + 4096 + 4096))[tid] = -1;
            pg8::EpiSwiGLU E{(bf16_t*)(ws + WS_HZ), DFF, (const float*)((unsigned char*)P.out() + OUT_SSQ) + (size_t)sqi * MT * 16, (LAS float*)(lds + 131072 + 4096)};
            pg8::gemm_phase<pg8::EpiSwiGLU, pg8::StaticOrder, true, true>(lds, g, S, E);
        } else if ((type == PH_FFN2 || type == PH_OUTPROJ) && EN(PH_FFN2)) {
            pg8::Gemm g;
            float scale;
            if (type == PH_FFN2) { g = pg8::Gemm{(const bf16_t*)(ws + WS_HZ), (const bf16_t*)(ws + WS_W2) + (size_t)(arg & 3) * D * DFF, MT, D, DFF}; scale = 0.5f; }
            else { g = pg8::Gemm{(const bf16_t*)(ws + WS_MIX), (const bf16_t*)(ws + ((arg & 3) ? WS_WOO : WS_WOE)), MT, D, D}; scale = 1.0f; }
            if (arg & 8) scale = 0.f;
            pg8::StaticOrder S; S.init(MT, D, G, cb);
            pg8::EpiResAdd E{(bf16_t*)(ws + WS_XN), D, scale, (float*)((unsigned char*)P.out() + OUT_SSQ) + (size_t)sqi * MT * 16};
            pg8::gemm_phase<pg8::EpiResAdd, pg8::StaticOrder, true, true>(lds, g, S, E);
        } else if (type == PH_RMS && EN(PH_RMS)) {
            const float* gain = arg < 4 ? P.in(2) + arg * D : (arg < 6 ? P.in(6) + (arg - 4) * D : P.in(24));
            rms_pass(P, gain, 2, gw, ngw, lane);
        } else if (type == PH_INPROJ && EN(PH_INPROJ)) {
            for (int part = 0; part < 2; ++part) {
                pg8::Gemm g; pg8::EpiStore E; pg8::StaticOrder S;
                if (part == 0) {
                    const int N = arg ? ZLD1 : ZLD0;
                    g = pg8::Gemm{(const bf16_t*)(ws + WS_XN), (const bf16_t*)(ws + (arg ? WS_WINO : WS_WINE)), MT, N, D};
                    E = pg8::EpiStore{(bf16_t*)(ws + WS_Z), (size_t)N, (const float*)((unsigned char*)P.out() + OUT_SSQ) + (size_t)sqi * MT * 16, 0}; S.init(MT, N, G, cb);
                } else {
                    const int NV = arg ? 256 : 512;
                    g = pg8::Gemm{(const bf16_t*)(ws + (arg ? WS_WVO : WS_WVE)), (const bf16_t*)(ws + WS_XN), NV, MT, D};
                    E = pg8::EpiStore{(bf16_t*)(ws + WS_VT), (size_t)MT, (const float*)((unsigned char*)P.out() + OUT_SSQ) + (size_t)sqi * MT * 16, 1}; S.init(NV, MT, G, cb);
                }
                pg8::gemm_phase<pg8::EpiStore, pg8::StaticOrder, true, true>(lds, g, S, E);
            }
        } else if (type == PH_MIX0 && EN(PH_MIX0)) {
            {
                const int i = wave * G + cb, nw = 8 * G;
                for (int t = i; t < 1280; t += nw) {
                    int pair, dir, g, s0;
                    if (t < 256) { pair = t >> 6; dir = (t >> 5) & 1; g = t & 31; s0 = 2 * pair; } else { const int u = t - 256; pair = u >> 6; dir = (u >> 5) & 1; g = u & 31; s0 = 8 + 2 * pair; }
                    __builtin_amdgcn_s_setprio(3);
                    if (dir) s5_task2<1>(P, s0, s0 + 1, g, wl, lane); else s5_task2<0>(P, s0, s0 + 1, g, wl, lane);
                    __builtin_amdgcn_s_setprio(0);
                }
                const unsigned myx = xb_xcc_id() & 7u;
                for (unsigned step = 0; step < 8u; ++step) {
                    const unsigned q = (myx + step) & 7u;
                    unsigned* ctr = (unsigned*)(ws + WS_CTR) + 64 * q;
                    for (;;) {
                        unsigned t0 = 0;
                        if (lane == 0) t0 = __hip_atomic_fetch_add(ctr, 2u, __ATOMIC_RELAXED, __HIP_MEMORY_SCOPE_AGENT);
                        t0 = (unsigned)__builtin_amdgcn_readfirstlane((int)t0);
                        if (t0 >= 1536u) break;
                        const int tk = (int)(q * 1536u + t0);
                        na_fill_table(P, (tk >> 2) & 7, (LAS float*)(wl + 9216), lane);
                        for (int k = 0; k < 2; ++k) na_task4(P, tk + k, (LAS float*)(wl + 9216), lane);
                    }
                }
            }
        } else if (type == PH_COMB && EN(PH_COMB)) {
            s5_combine(P, cb * NTHREADS + tid, G * NTHREADS);
        } else if (type == PH_GLU && EN(PH_GLU)) {
            const bf16_t* Gp = (const bf16_t*)((unsigned char*)P.out() + OUT_G);
            pg8::Gemm g{Gp, (const bf16_t*)(ws + WS_WGLU), MT, 512, 512};
            pg8::StaticOrder S; S.init(MT, 512, G, cb);
            pg8::EpiGLU E{Gp, 512, P.in(17), (bf16_t*)(ws + WS_MIX), D};
            pg8::gemm_phase<pg8::EpiGLU, pg8::StaticOrder, true, true>(lds, g, S, E);
        } else if (type == PH_NOP) {
            if (arg == 1 && cb == 0 && tid < 8) ((unsigned*)(ws + WS_CTR))[64 * tid] = 0u;
        } else if (type == PH_GQA && EN(PH_GQA)) {
            gqa_phase(P, lds, tid, cb, G);
        }
        if (ph + 1 < NPH) { if (ph == 0) grid.sync(); else xcd_barrier(xbar); }
    }
}

extern "C" void kernel_launch(void* const* d_in, const int* in_sizes, int n_in, void* d_out, int out_size, void* d_ws, size_t ws_size, hipStream_t stream) {
    static int grid = 0;
    if (grid == 0) {
        if (n_in != 25 || out_size != MT * D || ws_size < WS_END) { fprintf(stderr, "kernel_launch: unexpected shapes: n_in %d out %d ws %zu (need %zu)\n", n_in, out_size, ws_size, (size_t)WS_END); grid = -1; return; }
        int dev = 0, cus = 0, per_cu = 0;
        (void)hipGetDevice(&dev);
        (void)hipDeviceGetAttribute(&cus, hipDeviceAttributeMultiprocessorCount, dev);
        if (hipFuncSetAttribute((const void*)mk_fwd, hipFuncAttributeMaxDynamicSharedMemorySize, LDS_BYTES) != hipSuccess) { fprintf(stderr, "kernel_launch: hipFuncSetAttribute failed\n"); grid = -1; return; }
        if (hipOccupancyMaxActiveBlocksPerMultiprocessor(&per_cu, (const void*)mk_fwd, NTHREADS, LDS_BYTES) != hipSuccess || per_cu < 1) { fprintf(stderr, "kernel_launch: occupancy query says %d blocks per CU\n", per_cu); (void)hipGetLastError(); per_cu = 1; }
        grid = cus;
    }
    if (grid < 0) return;
    if (hipMemsetAsync(d_ws, 0, 65536, stream) != hipSuccess) { fprintf(stderr, "kernel_launch: memset failed\n"); return; }
    Params p{};
    for (int i = 0; i < 25; ++i) p.in[i] = (const float*)d_in[i];
    p.out = (float*)d_out; p.ws = (unsigned char*)d_ws;
    void* args[] = {&p};
    hipError_t e = hipLaunchCooperativeKernel((const void*)mk_fwd, dim3(grid), dim3(NTHREADS), args, LDS_BYTES, stream);
    if (e != hipSuccess) fprintf(stderr, "kernel_launch: cooperative launch failed: %s (grid %d)\n", hipGetErrorString(e), grid);
}
```
